# Optimizing an MI355X kernel written in HIP

```python
import jax, jax.numpy as jnp
from jax import lax
import numpy as np

D_MODEL = 4096
BATCH = 1
SEQ = 16384
DEPTH = 1
DEC_BATCH = 8
DEC_SEQ = 16
PAST_LEN = 2048

CHUNK = 64
HEAD_DIM = 128
GDN_QK_HEADS = 8
GDN_V_HEADS = 16
GDN_QK_WIDTH = GDN_QK_HEADS * HEAD_DIM
GDN_V_WIDTH = GDN_V_HEADS * HEAD_DIM
CONV_WIDTH = 4
CONV_CH = 2 * GDN_QK_WIDTH + GDN_V_WIDTH
SB_HEADS = 16
SB_WIDTH = SB_HEADS * HEAD_DIM
SB_BLOCK = 128
SB_SEG = 2048
D_FF = 4 * D_MODEL
EPS = 1e-6
FAR_POS = 2 ** 30

OFF_Z = CONV_CH
OFF_A = OFF_Z + GDN_V_WIDTH
OFF_B = OFF_A + GDN_V_HEADS
OFF_SB = OFF_B + GDN_V_HEADS
OFF_GATE = OFF_SB + 3 * SB_WIDTH
IN_WIDTH = OFF_GATE + 2 * D_MODEL

kernel_name = "hybrid_gdn_stickbreaking_stream_step"


def rmsnorm(x, w):
    xf = x.astype(jnp.float32)
    var = jnp.mean(xf * xf, axis=-1, keepdims=True)
    return (xf * lax.rsqrt(var + EPS) * w.astype(jnp.float32)).astype(x.dtype)


def l2norm(t):
    return t * lax.rsqrt(jnp.sum(t * t, axis=-1, keepdims=True) + EPS)


def causal_conv_silu(x, past, w):
    L = x.shape[1]
    xp = jnp.concatenate([past.astype(x.dtype), x], axis=1)
    out = w[0] * xp[:, 0:L]
    for i in range(1, CONV_WIDTH):
        out = out + w[i] * xp[:, i:i + L]
    return jax.nn.silu(out), xp[:, -(CONV_WIDTH - 1):]


def _to_blocks(t, chunk):
    B, L, H = t.shape[:3]
    t = t.reshape((B, L // chunk, chunk, H) + t.shape[3:])
    return jnp.moveaxis(t, (1, 3), (0, 2))


def gated_delta_rule(q, k, v, g, beta, S0, chunk):
    B, L, H, dk = k.shape
    dv = v.shape[-1]
    qc, kc, vc = _to_blocks(q, chunk), _to_blocks(k, chunk), _to_blocks(v, chunk)
    gc = jnp.cumsum(_to_blocks(g, chunk), axis=-1)
    bc = _to_blocks(beta, chunk)
    idx = jnp.arange(chunk)
    causal = idx[:, None] >= idx[None, :]
    strict = idx[:, None] > idx[None, :]
    diff = gc[..., :, None] - gc[..., None, :]
    decay = jnp.where(causal, jnp.exp(jnp.where(causal, diff, 0.0)), 0.0)
    kk = jnp.einsum('nbhid,nbhjd->nbhij', kc, kc)
    tri = jnp.eye(chunk, dtype=jnp.float32) + jnp.where(strict, bc[..., :, None] * kk * decay, 0.0)
    rhs = jnp.concatenate([vc * bc[..., None], kc * (bc * jnp.exp(gc))[..., None]], axis=-1)
    sol = lax.linalg.triangular_solve(tri, rhs, left_side=True, lower=True, unit_diagonal=True)
    u0, w = sol[..., :dv], sol[..., dv:]
    aqk = jnp.einsum('nbhid,nbhjd->nbhij', qc, kc) * decay
    qg = qc * jnp.exp(gc)[..., None]
    g_last = gc[..., -1]
    kd = kc * jnp.exp(g_last[..., None] - gc)[..., None]

    def step(S, xs):
        u0_, w_, aqk_, qg_, kd_, gl_ = xs
        u = u0_ - jnp.einsum('bhcd,bhde->bhce', w_, S)
        o = jnp.einsum('bhcd,bhde->bhce', qg_, S) + jnp.einsum('bhij,bhje->bhie', aqk_, u)
        S = jnp.exp(gl_)[..., None, None] * S + jnp.einsum('bhcd,bhce->bhde', kd_, u)
        return S, o

    S, o = lax.scan(step, S0, (u0, w, aqk, qg, kd, g_last))
    o = jnp.moveaxis(o, (0, 2), (1, 3)).reshape(B, L, H, dv)
    return o, S


def stick_breaking(q, k, v, q_pos, k_pos):
    B, K, H, d = k.shape
    pad = (-K) % SB_BLOCK
    if pad:
        k = jnp.pad(k, ((0, 0), (0, pad), (0, 0), (0, 0)))
        v = jnp.pad(v, ((0, 0), (0, pad), (0, 0), (0, 0)))
        k_pos = jnp.concatenate([k_pos, jnp.full((pad,), FAR_POS, jnp.int32)])
    nk = (K + pad) // SB_BLOCK
    kb = k.reshape(B, nk, SB_BLOCK, H, d).astype(jnp.float32)
    vb = v.reshape(B, nk, SB_BLOCK, H, d).astype(jnp.float32)
    z = jnp.einsum('bqhd,bnkhd->bhqnk', q.astype(jnp.float32), kb) * (HEAD_DIM ** -0.5)
    mask = k_pos.reshape(nk, SB_BLOCK)[None] < q_pos[:, None, None]
    log_fail = jnp.where(mask, jax.nn.log_sigmoid(-z), 0.0)
    idx = jnp.arange(SB_BLOCK)
    upper = (idx[:, None] >= idx[None, :]).astype(jnp.float32)
    within = jnp.einsum('bhqnj,js->bhqns', log_fail, upper)
    totals = jnp.sum(log_fail, axis=-1)
    later = lax.cumsum(totals, axis=3, reverse=True) - totals
    tail = within + later[..., None] - log_fail
    att = jnp.where(mask, jnp.exp(jax.nn.log_sigmoid(z) + tail), 0.0)
    return jnp.einsum('bhqnk,bnkhd->bqhd', att, vb)


def stick_breaking_prompt(q, k, v):
    B, L, H, d = q.shape
    outs = []
    for s0 in range(0, L, SB_SEG):
        ls = min(SB_SEG, L - s0)
        nb = ls // SB_BLOCK
        kk, vv = k[:, :s0 + ls], v[:, :s0 + ls]
        k_pos = jnp.arange(s0 + ls, dtype=jnp.int32)
        qb = jnp.moveaxis(q[:, s0:s0 + ls].reshape(B, nb, SB_BLOCK, H, d), 1, 0)

        def one_block(args, kk=kk, vv=vv, k_pos=k_pos, s0=s0):
            q_blk, i = args
            q_pos = s0 + i * SB_BLOCK + jnp.arange(SB_BLOCK, dtype=jnp.int32)
            return stick_breaking(q_blk, kk, vv, q_pos, k_pos)

        o = lax.map(one_block, (qb, jnp.arange(nb, dtype=jnp.int32)))
        outs.append(jnp.moveaxis(o, 0, 1).reshape(B, ls, H * d))
    return jnp.concatenate(outs, axis=1)


def layer(x, conv_past, S0, past_k, past_v, chunk,
          norm1_w, w_in, conv_w, A_log, dt_bias, gdn_norm_w, w_gdn_o, w_sb_o, w_out,
          norm2_w, w_up, w_down):
    B, L, _ = x.shape
    xn = rmsnorm(x, norm1_w)
    proj = xn @ w_in
    qkv_raw, z, a, b, sb_qkv, gates = jnp.split(proj, [OFF_Z, OFF_A, OFF_B, OFF_SB, OFF_GATE], axis=-1)

    qkv, conv_state = causal_conv_silu(qkv_raw, conv_past, conv_w)
    qkv = qkv.astype(jnp.float32)
    q, k, v = jnp.split(qkv, [GDN_QK_WIDTH, 2 * GDN_QK_WIDTH], axis=-1)
    rep = GDN_V_HEADS // GDN_QK_HEADS
    q = jnp.repeat(l2norm(q.reshape(B, L, GDN_QK_HEADS, HEAD_DIM)) * (HEAD_DIM ** -0.5), rep, axis=2)
    k = jnp.repeat(l2norm(k.reshape(B, L, GDN_QK_HEADS, HEAD_DIM)), rep, axis=2)
    v = v.reshape(B, L, GDN_V_HEADS, HEAD_DIM)
    g = -jnp.exp(A_log.astype(jnp.float32)) * jax.nn.softplus(a.astype(jnp.float32) + dt_bias.astype(jnp.float32))
    beta = jax.nn.sigmoid(b.astype(jnp.float32))
    o_a, S = gated_delta_rule(q, k, v, g, beta, S0.astype(jnp.float32), chunk)
    o_a = rmsnorm(o_a, gdn_norm_w) * jax.nn.silu(z.astype(jnp.float32).reshape(B, L, GDN_V_HEADS, HEAD_DIM))
    y_a = o_a.reshape(B, L, GDN_V_WIDTH).astype(x.dtype) @ w_gdn_o

    q_sb, k_sb, v_sb = [t.reshape(B, L, SB_HEADS, HEAD_DIM) for t in jnp.split(sb_qkv, 3, axis=-1)]
    if past_k is None:
        o_b = stick_breaking_prompt(q_sb, k_sb, v_sb)
    else:
        P = past_k.shape[1]
        keys = jnp.concatenate([past_k.astype(x.dtype), k_sb], axis=1)
        vals = jnp.concatenate([past_v.astype(x.dtype), v_sb], axis=1)
        q_pos = P + jnp.arange(L, dtype=jnp.int32)
        k_pos = jnp.arange(P + L, dtype=jnp.int32)
        o_b = stick_breaking(q_sb, keys, vals, q_pos, k_pos).reshape(B, L, SB_WIDTH)
    y_b = o_b.astype(x.dtype) @ w_sb_o

    g_a, g_b = jnp.split(jax.nn.sigmoid(gates), 2, axis=-1)
    h = x + (g_a * y_a + g_b * y_b) @ w_out

    h = h + jnp.square(jax.nn.relu(rmsnorm(h, norm2_w) @ w_up)) @ w_down
    return h, conv_state, S.astype(S0.dtype), k_sb, v_sb


def setup_inputs(seed: int = 0) -> dict:
    key = jax.random.key(seed)
    ks = jax.random.split(key, 24)

    def nrm(k, shape, scale):
        return jax.random.normal(k, shape, jnp.float32) * scale

    dt = jnp.exp(jax.random.uniform(ks[9], (DEPTH, GDN_V_HEADS), jnp.float32,
                                    np.log(1e-3).astype(np.float32), np.log(1e-1).astype(np.float32)))
    return {
        "x_prompt": nrm(ks[0], (BATCH, SEQ, D_MODEL), 1.0),
        "x_sample": nrm(ks[1], (DEC_BATCH, DEC_SEQ, D_MODEL), 1.0),
        "cache_sb_k": nrm(ks[2], (DEPTH, DEC_BATCH, PAST_LEN, SB_HEADS, HEAD_DIM), 1.0),
        "cache_sb_v": nrm(ks[3], (DEPTH, DEC_BATCH, PAST_LEN, SB_HEADS, HEAD_DIM), 1.0),
        "state_gdn_S": nrm(ks[4], (DEPTH, DEC_BATCH, GDN_V_HEADS, HEAD_DIM, HEAD_DIM), 0.1),
        "state_gdn_conv": nrm(ks[5], (DEPTH, DEC_BATCH, CONV_WIDTH - 1, CONV_CH), 1.0),
        "norm1_w": 1.0 + nrm(ks[6], (DEPTH, D_MODEL), 0.01),
        "w_in": nrm(ks[7], (DEPTH, D_MODEL, IN_WIDTH), D_MODEL ** -0.5),
        "conv_w": nrm(ks[8], (DEPTH, CONV_WIDTH, CONV_CH), CONV_WIDTH ** -0.5),
        "A_log": jnp.log(jax.random.uniform(ks[10], (DEPTH, GDN_V_HEADS), jnp.float32, 1.0, 16.0)),
        "dt_bias": dt + jnp.log(-jnp.expm1(-dt)),
        "gdn_norm_w": 1.0 + nrm(ks[11], (DEPTH, HEAD_DIM), 0.01),
        "w_gdn_o": nrm(ks[12], (DEPTH, GDN_V_WIDTH, D_MODEL), GDN_V_WIDTH ** -0.5),
        "w_sb_o": nrm(ks[13], (DEPTH, SB_WIDTH, D_MODEL), SB_WIDTH ** -0.5),
        "w_out": nrm(ks[14], (DEPTH, D_MODEL, D_MODEL), D_MODEL ** -0.5),
        "norm2_w": 1.0 + nrm(ks[15], (DEPTH, D_MODEL), 0.01),
        "w_up": nrm(ks[16], (DEPTH, D_MODEL, D_FF), D_MODEL ** -0.5),
        "w_down": nrm(ks[17], (DEPTH, D_FF, D_MODEL), D_FF ** -0.5),
        "final_norm_w": 1.0 + nrm(ks[18], (D_MODEL,), 0.01),
    }


def reference(x_prompt, x_sample, cache_sb_k, cache_sb_v, state_gdn_S, state_gdn_conv,
              norm1_w, w_in, conv_w, A_log, dt_bias, gdn_norm_w, w_gdn_o, w_sb_o, w_out,
              norm2_w, w_up, w_down, final_norm_w):
    hp, hs = x_prompt, x_sample
    Bp = x_prompt.shape[0]
    pk, pv, pS, pc, sk, sv, sS, sc = [], [], [], [], [], [], [], []
    for l in range(DEPTH):
        weights = (norm1_w[l], w_in[l], conv_w[l], A_log[l], dt_bias[l], gdn_norm_w[l],
                   w_gdn_o[l], w_sb_o[l], w_out[l], norm2_w[l], w_up[l], w_down[l])
        conv0 = jnp.zeros((Bp, CONV_WIDTH - 1, CONV_CH), hp.dtype)
        S0 = jnp.zeros((Bp, GDN_V_HEADS, HEAD_DIM, HEAD_DIM), state_gdn_S.dtype)
        hp, c_p, S_p, k_p, v_p = layer(hp, conv0, S0, None, None, CHUNK, *weights)
        hs, c_s, S_s, k_s, v_s = layer(hs, state_gdn_conv[l], state_gdn_S[l], cache_sb_k[l], cache_sb_v[l],
                                       hs.shape[1], *weights)
        pk.append(k_p); pv.append(v_p); pS.append(S_p); pc.append(c_p)
        sk.append(k_s); sv.append(v_s); sS.append(S_s); sc.append(c_s)
    y_prompt = rmsnorm(hp, final_norm_w)
    y_sample = rmsnorm(hs, final_norm_w)
    return (y_prompt, y_sample,
            jnp.stack(pk), jnp.stack(pv), jnp.stack(pS), jnp.stack(pc),
            jnp.stack(sk), jnp.stack(sv), jnp.stack(sS), jnp.stack(sc))
```

```cpp
#include <hip/hip_runtime.h>
#include <cstdio>
#include <cstdint>
#ifndef MK_N_LAUNCHES
#define MK_N_LAUNCHES 1
#endif
#ifndef DBG_STAGE
#define DBG_STAGE 0
#endif
#undef MK_N_LAUNCHES
#define MK_N_LAUNCHES 1
namespace pg8 {
#define PG8_LAS __attribute__((address_space(3)))
typedef unsigned short bf16_t;
typedef short bf16x8 __attribute__((ext_vector_type(8)));
typedef float f32x4 __attribute__((ext_vector_type(4)));
typedef unsigned u32x4 __attribute__((ext_vector_type(4)));
constexpr int BM = 256, BK = 64, HALF = 128, HTB = HALF * BK * 2  , STAGE_BYTES = 8 * HTB, NXCD = 8, WGM = 8;

__host__ __device__ __forceinline__ int lds_byte(int r, int c) { const int st = (r >> 4) * 2 + (c >> 5), rr = r & 15, cc = c & 31, ob = rr * 64 + cc * 2; return st * 1024 + (ob ^ (((ob >> 9) & 1) << 5)); }
__host__ __device__ __forceinline__ void stage_rc(int b, int& R, int& C) { const int st = b / 1024, sb = b % 1024, swz = sb ^ (((sb >> 9) & 1) << 5); R = (st >> 1) * 16 + swz / 64; C = (st & 1) * 32 + (swz % 64) / 2; }
__host__ __device__ __forceinline__ int perm32(int rho) { const int n = rho >> 4, i = rho & 15; return 8 * (i >> 2) + 4 * n + (i & 3); }

struct Unit { int pm, pn; };
struct Gemm { const bf16_t* A; const bf16_t* Bt; int M, N, K; };

struct StaticOrder {
    int nM, nN, nwg, G, c;
    __host__ __device__ void init(int M, int N, int G_, int c_) { nM = M / BM; nN = N / BM; nwg = nM * nN; G = G_; c = c_; }
    __host__ __device__ bool next(int i, Unit& u) const {
        const long L = (long)i * G + c; if (L >= nwg) return false;
        int wgid = (int)L; { const int q = nwg / NXCD, r = nwg % NXCD, xcd = wgid % NXCD, off = wgid / NXCD; wgid = (xcd < r ? xcd * (q + 1) : r * (q + 1) + (xcd - r) * q) + off; }
        const int nig = WGM * nN, gid = wgid / nig, fm = gid * WGM, gsz = (nM - fm) < WGM ? (nM - fm) : WGM;
        u.pm = fm + ((wgid % nig) % gsz); u.pn = (wgid % nig) / gsz; return true;
    }
    __device__ __forceinline__ void a_ready(const Unit&) const {}
    __device__ __forceinline__ void done(const Unit&) const {}
};
typedef float f32x2c __attribute__((ext_vector_type(2))); typedef __bf16 bf16x2c __attribute__((ext_vector_type(2)));
__device__ __forceinline__ unsigned cvt_pk_bf16(float lo, float hi) { const f32x2c v = {lo, hi}; return __builtin_bit_cast(unsigned, __builtin_convertvector(v, bf16x2c)); }
constexpr int PROWS = 16384, REALROWS = 16512;
constexpr size_t O_YP = 0, O_YS = 67108864, O_KP = 67633152, O_VP = 101187584, O_SP = 134742016, O_CP = 135004160, O_KS = 135016448, O_VS = 135278592, O_SS = 135540736, O_CS = 137637888, O_END = 137736192;
__device__ __forceinline__ float sigmoidf_fast(float x) { return __builtin_amdgcn_rcpf(1.0f + __expf(-x)); }
__device__ __forceinline__ u32x4 pack8(const f32x4 v0, const f32x4 v1) { u32x4 w; w.x = cvt_pk_bf16(v0[0], v0[1]); w.y = cvt_pk_bf16(v0[2], v0[3]); w.z = cvt_pk_bf16(v1[0], v1[1]); w.w = cvt_pk_bf16(v1[2], v1[3]); return w; }
__device__ __forceinline__ void unpack8(const u32x4 w, f32x4& v0, f32x4& v1) {
    v0[0] = __uint_as_float(w.x << 16); v0[1] = __uint_as_float(w.x & 0xffff0000u); v0[2] = __uint_as_float(w.y << 16); v0[3] = __uint_as_float(w.y & 0xffff0000u);
    v1[0] = __uint_as_float(w.z << 16); v1[1] = __uint_as_float(w.z & 0xffff0000u); v1[2] = __uint_as_float(w.w << 16); v1[3] = __uint_as_float(w.w & 0xffff0000u); }

struct EpiInProj {
    static constexpr bool PERM = true, AFTER_DRAIN = false;
    bf16_t *qkvraw, *z, *qsb, *ksb, *vsb, *gates; float* ab; float* out;
    __device__ __forceinline__ void operator()(const f32x4 (&acc)[2][2][4][2], const Unit& u, int wr, int wc, int fr, int fq) const {
        const int pn = u.pn, row0 = u.pm * BM + wr * 64 + fr, cl = wc * 32 + 8 * fq;
        if (pn == 80) {
            if (wc == 0) {
#pragma unroll
                for (int ai = 0; ai < 2; ++ai)
#pragma unroll
                    for (int m = 0; m < 4; ++m) { float* p = ab + (size_t)(row0 + ai * HALF + m * 16) * 32 + cl; *(f32x4*)p = acc[ai][0][m][0]; *(f32x4*)(p + 4) = acc[ai][0][m][1]; }
            }
            return;
        }
        bf16_t* base; int ldc, c0, mode = 0; float* fp = nullptr; float* fs = nullptr;
        if (pn < 16) { base = qkvraw; ldc = 4096; c0 = pn * 256; mode = 3; }
        else if (pn < 24) { base = z; ldc = 2048; c0 = (pn - 16) * 256; }
        else if (pn < 32) { base = qsb; ldc = 2048; c0 = (pn - 24) * 256; }
        else if (pn < 40) { base = ksb; ldc = 2048; c0 = (pn - 32) * 256; mode = 2; fp = out + O_KP; fs = out + O_KS; }
        else if (pn < 48) { base = vsb; ldc = 2048; c0 = (pn - 40) * 256; mode = 2; fp = out + O_VP; fs = out + O_VS; }
        else { base = gates; ldc = 8192; c0 = (pn - 48) * 256; mode = 1; }
#pragma unroll
        for (int ai = 0; ai < 2; ++ai)
#pragma unroll
            for (int m = 0; m < 4; ++m) { const int row = row0 + ai * HALF + m * 16;
#pragma unroll
                for (int bj = 0; bj < 2; ++bj) { f32x4 v0 = acc[ai][bj][m][0], v1 = acc[ai][bj][m][1]; const int col = c0 + bj * HALF + cl;
                    if (mode == 1) {
#pragma unroll
                        for (int j = 0; j < 4; ++j) { v0[j] = sigmoidf_fast(v0[j]); v1[j] = sigmoidf_fast(v1[j]); } }
                    *(u32x4*)(base + (size_t)row * ldc + col) = pack8(v0, v1);
                    if (mode == 2 && row < REALROWS) { float* p = (row < PROWS) ? fp + (size_t)row * 2048 + col : fs + (size_t)(row - PROWS) * 2048 + col; *(f32x4*)p = v0; *(f32x4*)(p + 4) = v1; }
                    if (mode == 3) {
                        if (row >= PROWS - 3 && row < PROWS) { float* p = out + O_CP + (size_t)(row - (PROWS - 3)) * 4096 + col; *(f32x4*)p = v0; *(f32x4*)(p + 4) = v1; }
                        else if (row >= PROWS && row < REALROWS && ((row - PROWS) & 15) >= 13) { const int sr = row - PROWS; float* p = out + O_CS + (size_t)((sr >> 4) * 3 + (sr & 15) - 13) * 4096 + col; *(f32x4*)p = v0; *(f32x4*)(p + 4) = v1; } }
                } }
    }
};
template <int BR> struct EpiGate {
    static constexpr bool PERM = true, AFTER_DRAIN = false;
    const bf16_t* gates; bf16_t* mo;
    __device__ __forceinline__ void operator()(const f32x4 (&acc)[2][2][4][2], const Unit& u, int wr, int wc, int fr, int fq) const {
        const int row0 = u.pm * BM + wr * 64 + fr, col0 = u.pn * BM + wc * 32 + 8 * fq;
#pragma unroll
        for (int ai = 0; ai < 2; ++ai)
#pragma unroll
            for (int m = 0; m < 4; ++m) { const size_t row = (size_t)(row0 + ai * HALF + m * 16);
#pragma unroll
                for (int bj = 0; bj < 2; ++bj) { const int col = col0 + bj * HALF; f32x4 g0, g1; unpack8(*(const u32x4*)(gates + row * 8192 + BR * 4096 + col), g0, g1);
                    f32x4 v0 = acc[ai][bj][m][0] * g0, v1 = acc[ai][bj][m][1] * g1;
                    if (BR == 1) { f32x4 p0, p1; unpack8(*(const u32x4*)(mo + row * 4096 + col), p0, p1); v0 = v0 + p0; v1 = v1 + p1; }
                    *(u32x4*)(mo + row * 4096 + col) = pack8(v0, v1); } }
    }
};
struct EpiOutRes {
    static constexpr bool PERM = false, AFTER_DRAIN = false;
    const float* xp; const float* xs; float* h;
    __device__ __forceinline__ void operator()(const f32x4 (&acc)[2][2][4][2], const Unit& u, int wr, int wc, int fr, int fq) const {
        const int row0 = u.pm * BM + wr * 64 + fr, col0 = u.pn * BM + wc * 32 + 4 * fq;
#pragma unroll
        for (int ai = 0; ai < 2; ++ai)
#pragma unroll
            for (int m = 0; m < 4; ++m) { const int row = row0 + ai * HALF + m * 16; if (row >= REALROWS) continue;
                const float* xr = (row < PROWS) ? xp + (size_t)row * 4096 : xs + (size_t)(row - PROWS) * 4096; float* hr = h + (size_t)row * 4096;
#pragma unroll
                for (int bj = 0; bj < 2; ++bj)
#pragma unroll
                    for (int n = 0; n < 2; ++n) { const int c = col0 + bj * HALF + n * 16; *(f32x4*)(hr + c) = *(const f32x4*)(xr + c) + acc[ai][bj][m][n]; } }
    }
};
struct EpiUp {
    static constexpr bool PERM = true, AFTER_DRAIN = false;
    bf16_t* U;
    __device__ __forceinline__ void operator()(const f32x4 (&acc)[2][2][4][2], const Unit& u, int wr, int wc, int fr, int fq) const {
        const int row0 = u.pm * BM + wr * 64 + fr, col0 = u.pn * BM + wc * 32 + 8 * fq;
#pragma unroll
        for (int ai = 0; ai < 2; ++ai)
#pragma unroll
            for (int m = 0; m < 4; ++m) { bf16_t* rowp = U + (size_t)(row0 + ai * HALF + m * 16) * 16384 + col0;
#pragma unroll
                for (int bj = 0; bj < 2; ++bj) { f32x4 v0 = acc[ai][bj][m][0], v1 = acc[ai][bj][m][1];
#pragma unroll
                    for (int j = 0; j < 4; ++j) { const float a = fmaxf(v0[j], 0.f), b = fmaxf(v1[j], 0.f); v0[j] = a * a; v1[j] = b * b; }
                    *(u32x4*)(rowp + bj * HALF) = pack8(v0, v1); } }
    }
};
struct EpiDownRes {
    static constexpr bool PERM = false, AFTER_DRAIN = false;
    float* h;
    __device__ __forceinline__ void operator()(const f32x4 (&acc)[2][2][4][2], const Unit& u, int wr, int wc, int fr, int fq) const {
        const int row0 = u.pm * BM + wr * 64 + fr, col0 = u.pn * BM + wc * 32 + 4 * fq;
#pragma unroll
        for (int ai = 0; ai < 2; ++ai)
#pragma unroll
            for (int m = 0; m < 4; ++m) { const int row = row0 + ai * HALF + m * 16; if (row >= REALROWS) continue; float* hr = h + (size_t)row * 4096;
#pragma unroll
                for (int bj = 0; bj < 2; ++bj)
#pragma unroll
                    for (int n = 0; n < 2; ++n) { const int c = col0 + bj * HALF + n * 16; *(f32x4*)(hr + c) = *(const f32x4*)(hr + c) + acc[ai][bj][m][n]; } }
    }
};
template <class Epi, class Sched, bool ALIGN_EPI = false, bool SP2 = false>
__device__ __forceinline__ void gemm_phase(PG8_LAS unsigned char* lds, const Gemm g, const Sched& S, const Epi& E) {
    int tid = threadIdx.x; asm volatile("" : "+v"(tid));
    const int wid = __builtin_amdgcn_readfirstlane(tid >> 6), lane = tid & 63, wr = wid >> 2, wc = wid & 3, fr = lane & 15, fq = lane >> 4;
    const int K = g.K, nt = K / BK;
    unsigned voffA[2], voffB[2];
#pragma unroll
    for (int i = 0; i < 2; ++i) { int R, C; stage_rc(tid * 16 + i * 8192, R, C); const int Rb = Epi::PERM ? ((R & ~31) + perm32(R & 31)) : R;
        voffA[i] = (unsigned)(R * K + C) * 2u; voffB[i] = (unsigned)(Rb * K + C) * 2u; }
    const size_t kstep = (size_t)(BK * 2);
    const size_t hstep = (size_t)HALF * K * 2;
    const size_t tstep = 2 * hstep;
    const unsigned ldsw = (unsigned)wid * 1024u;
    const int aoff = lds_byte(wr * 64 + fr, fq * 8), boff = lds_byte(wc * 32 + fr, fq * 8);
#define PG8_SA(b, h) (((b) * 2 + (h)) * HTB)
#define PG8_SB(b, h) ((4 + (b) * 2 + (h)) * HTB)
#define PG8_STAGE(bufoff, gbase, voff) do { _Pragma("unroll") for (int _i = 0; _i < 2; ++_i) \
        __builtin_amdgcn_global_load_lds((const unsigned*)((const char*)(gbase) + (voff)[_i]), (PG8_LAS unsigned*)(lds + (bufoff) + ldsw + _i * 8192), 16, 0, 0); } while (0)
#define PG8_LDA(dst, b, h) do { _Pragma("unroll") for (int m = 0; m < 4; ++m) _Pragma("unroll") for (int k = 0; k < 2; ++k) dst[m][k] = *(const PG8_LAS bf16x8*)(lds + PG8_SA(b, h) + aoff + m * 2048 + k * 1024); } while (0)
#define PG8_LDB(dst, b, h) do { _Pragma("unroll") for (int n = 0; n < 2; ++n) _Pragma("unroll") for (int k = 0; k < 2; ++k) dst[n][k] = *(const PG8_LAS bf16x8*)(lds + PG8_SB(b, h) + boff + n * 2048 + k * 1024); } while (0)
#define PG8_MMA(ai, bj, At, Bt) do { __builtin_amdgcn_s_setprio(1); _Pragma("unroll") for (int m = 0; m < 4; ++m) _Pragma("unroll") for (int n = 0; n < 2; ++n) _Pragma("unroll") for (int k = 0; k < 2; ++k) \
        acc[ai][bj][m][n] = __builtin_amdgcn_mfma_f32_16x16x32_bf16(Bt[n][k], At[m][k], acc[ai][bj][m][n], 0, 0, 0); __builtin_amdgcn_s_setprio(0); } while (0)
#define PG8_WAIT_V(n) asm volatile("s_waitcnt vmcnt(" #n ")" ::: "memory")
#define PG8_WAIT_L(n) asm volatile("s_waitcnt lgkmcnt(" #n ")" ::: "memory")
#define PG8_BAR __builtin_amdgcn_s_barrier()
#define PG8_SCHED __builtin_amdgcn_sched_barrier(0)
    Unit cur, nxt; int ui = 0;
    if (!S.next(0, cur)) return;
    f32x4 acc[2][2][4][2];
#pragma unroll
    for (int a = 0; a < 2; ++a)
#pragma unroll
        for (int b = 0; b < 2; ++b)
#pragma unroll
            for (int m = 0; m < 4; ++m)
#pragma unroll
                for (int n = 0; n < 2; ++n) acc[a][b][m][n] = (f32x4){0.f, 0.f, 0.f, 0.f};
    bf16x8 At[4][2], B0[2][2], B1[2][2];
    const char* cA = (const char*)g.A + (size_t)cur.pm * tstep; const char* cB = (const char*)g.Bt + (size_t)cur.pn * tstep;
    S.a_ready(cur);
    if constexpr (SP2) {
        PG8_STAGE(PG8_SB(0, 0), cB, voffB); PG8_STAGE(PG8_SB(0, 1), cB + hstep, voffB); PG8_STAGE(PG8_SA(0, 0), cA, voffA); PG8_STAGE(PG8_SA(0, 1), cA + hstep, voffA);
        if (wr == 1) PG8_BAR;
        PG8_WAIT_V(2); PG8_BAR;
        PG8_STAGE(PG8_SB(1, 0), cB + kstep, voffB); PG8_STAGE(PG8_SA(1, 0), cA + kstep, voffA); PG8_STAGE(PG8_SB(1, 1), cB + hstep + kstep, voffB);
        PG8_WAIT_V(6); PG8_BAR;
    } else {
        PG8_STAGE(PG8_SB(0, 0), cB, voffB); PG8_STAGE(PG8_SA(0, 0), cA, voffA); PG8_STAGE(PG8_SB(0, 1), cB + hstep, voffB); PG8_STAGE(PG8_SA(0, 1), cA + hstep, voffA);
        if (wr == 1) PG8_BAR;
        PG8_WAIT_V(4); PG8_BAR;
        PG8_STAGE(PG8_SB(1, 0), cB + kstep, voffB); PG8_STAGE(PG8_SA(1, 0), cA + kstep, voffA); PG8_STAGE(PG8_SB(1, 1), cB + hstep + kstep, voffB);
        PG8_WAIT_V(6); PG8_BAR;
    }
    for (;;) {
        const bool has_next = S.next(ui + 1, nxt);
        const char* nA = has_next ? (const char*)g.A + (size_t)nxt.pm * tstep : cA; const char* nB = has_next ? (const char*)g.Bt + (size_t)nxt.pn * tstep : cB;
        for (int t = 0; t < nt; t += 2) {
            const bool last = (t == nt - 2);
            const char* a1 = cA + (size_t)(t + 1) * kstep;
            const char* a2 = last ? nA : cA + (size_t)(t + 2) * kstep; const char* b2 = last ? nB : cB + (size_t)(t + 2) * kstep;
            const char* a3 = a2 + kstep; const char* b3 = b2 + kstep;
            if (last && has_next) S.a_ready(nxt);
            if constexpr (SP2) {
            PG8_LDB(B0, 0, 0); PG8_LDB(B1, 0, 1); PG8_SCHED; PG8_LDA(At, 0, 0); PG8_STAGE(PG8_SA(1, 1), a1 + hstep, voffA);
            PG8_WAIT_V(8); PG8_WAIT_L(0); PG8_BAR; PG8_MMA(0, 0, At, B0); PG8_MMA(0, 1, At, B1); PG8_BAR; PG8_SCHED;
            PG8_LDA(At, 0, 1); PG8_STAGE(PG8_SB(0, 0), b2, voffB); PG8_STAGE(PG8_SB(0, 1), b2 + hstep, voffB); PG8_STAGE(PG8_SA(0, 0), a2, voffA);
            PG8_WAIT_V(8); PG8_WAIT_L(0); PG8_BAR; PG8_MMA(1, 0, At, B0); PG8_MMA(1, 1, At, B1); PG8_BAR; PG8_SCHED;
            PG8_LDB(B0, 1, 0); PG8_LDB(B1, 1, 1); PG8_SCHED; PG8_LDA(At, 1, 0); PG8_STAGE(PG8_SA(0, 1), a2 + hstep, voffA);
            PG8_WAIT_V(8); PG8_WAIT_L(0); PG8_BAR; PG8_MMA(0, 0, At, B0); PG8_MMA(0, 1, At, B1); PG8_BAR; PG8_SCHED;
            PG8_LDA(At, 1, 1); PG8_STAGE(PG8_SB(1, 0), b3, voffB); PG8_STAGE(PG8_SB(1, 1), b3 + hstep, voffB); PG8_STAGE(PG8_SA(1, 0), a3, voffA);
            PG8_WAIT_V(8); PG8_WAIT_L(0); PG8_BAR; PG8_MMA(1, 0, At, B0); PG8_MMA(1, 1, At, B1); PG8_BAR; PG8_SCHED;
            } else {
            PG8_LDB(B0, 0, 0); PG8_SCHED; PG8_LDA(At, 0, 0); PG8_STAGE(PG8_SA(1, 1), a1 + hstep, voffA);
            PG8_WAIT_L(8); PG8_BAR; PG8_WAIT_L(0); PG8_MMA(0, 0, At, B0); PG8_BAR; PG8_SCHED;
            PG8_LDB(B1, 0, 1); PG8_STAGE(PG8_SB(0, 0), b2, voffB);
            PG8_BAR; PG8_WAIT_L(0); PG8_MMA(0, 1, At, B1); PG8_BAR;
            PG8_LDA(At, 0, 1); PG8_STAGE(PG8_SA(0, 0), a2, voffA);
            PG8_BAR; PG8_WAIT_L(0); PG8_MMA(1, 0, At, B0); PG8_BAR; PG8_SCHED;
            PG8_STAGE(PG8_SB(0, 1), b2 + hstep, voffB);
            PG8_WAIT_V(6); PG8_BAR; PG8_MMA(1, 1, At, B1); PG8_BAR;
            PG8_LDB(B0, 1, 0); PG8_SCHED; PG8_LDA(At, 1, 0); PG8_STAGE(PG8_SA(0, 1), a2 + hstep, voffA);
            PG8_WAIT_L(8); PG8_BAR; PG8_WAIT_L(0); PG8_MMA(0, 0, At, B0); PG8_BAR; PG8_SCHED;
            PG8_LDB(B1, 1, 1); PG8_STAGE(PG8_SB(1, 0), b3, voffB);
            PG8_BAR; PG8_WAIT_L(0); PG8_MMA(0, 1, At, B1); PG8_BAR;
            PG8_LDA(At, 1, 1); PG8_STAGE(PG8_SA(1, 0), a3, voffA);
            PG8_BAR; PG8_WAIT_L(0); PG8_MMA(1, 0, At, B0); PG8_BAR; PG8_SCHED;
            PG8_STAGE(PG8_SB(1, 1), b3 + hstep, voffB);
            PG8_WAIT_V(6); PG8_BAR; PG8_MMA(1, 1, At, B1); PG8_BAR;
            }
        }
        if constexpr (ALIGN_EPI) { if (wr == 0) PG8_BAR; }
        if constexpr (!Epi::AFTER_DRAIN) { E(acc, cur, wr, wc, fr, fq); S.done(cur); }
        if (!has_next) break;
#pragma unroll
        for (int a = 0; a < 2; ++a)
#pragma unroll
            for (int b = 0; b < 2; ++b)
#pragma unroll
                for (int m = 0; m < 4; ++m)
#pragma unroll
                    for (int n = 0; n < 2; ++n) acc[a][b][m][n] = (f32x4){0.f, 0.f, 0.f, 0.f};
        cur = nxt; cA = nA; cB = nB; ++ui;
        if constexpr (ALIGN_EPI) { if (wr == 1) PG8_BAR; }
    }
    PG8_WAIT_V(0);
    if constexpr (!ALIGN_EPI) { if (wr == 0) PG8_BAR; }
    PG8_BAR;
    if constexpr (Epi::AFTER_DRAIN) { E.fused(acc, cur, wr, wc, fr, fq, lds, wid, lane); S.done(cur); }
#undef PG8_SA
#undef PG8_SB
#undef PG8_STAGE
#undef PG8_LDA
#undef PG8_LDB
#undef PG8_MMA
#undef PG8_WAIT_V
#undef PG8_WAIT_L
#undef PG8_BAR
#undef PG8_SCHED
}
}
constexpr int NWAVES = 8;
constexpr int D = 4096, SEQ = 16384, MT = 16640, DFF = 16384, NIN = 20736;
constexpr int PROWS = pg8::PROWS, REALROWS = pg8::REALROWS;
constexpr int NPH = 13;
constexpr size_t MiB = 1u << 20;
constexpr size_t WS_CTL = 0, CTL_ZERO_BYTES = 1 * MiB;
constexpr size_t WS_WUP = 1 * MiB, WS_WDOWN = 129 * MiB, WS_WOUT = 257 * MiB, WS_WGDN = 289 * MiB, WS_WSB = 305 * MiB;
constexpr size_t WS_XN = 321 * MiB;
constexpr size_t WS_GATES = 451 * MiB;
constexpr size_t WS_WIN = 711 * MiB;
constexpr size_t WS_QKVRAW = 873 * MiB;
constexpr size_t WS_Z = 1003 * MiB, WS_QSB = 1068 * MiB, WS_KSB = 1133 * MiB, WS_VSB = 1198 * MiB;
constexpr size_t WS_AB = 1263 * MiB, WS_GB = 1266 * MiB;
constexpr size_t WS_OA = 1269 * MiB, WS_OB = 1334 * MiB;
constexpr size_t WS_EV = 1399 * MiB;
constexpr size_t WS_AQK = 1401 * MiB, WS_KT = 1433 * MiB;
constexpr size_t WS_SMP = 1465 * MiB;
constexpr size_t WS_END = 1467 * MiB;
constexpr size_t WS_GQ = WS_WIN, WS_GK = WS_WIN + 33 * MiB, WS_GVT = WS_WIN + 66 * MiB;
constexpr size_t WS_U0F = WS_XN, WS_W = WS_XN + 64 * MiB;
constexpr size_t WS_M = WS_QKVRAW, WS_U = WS_WIN;
static_assert(WS_GVT + 64 * MiB <= WS_QKVRAW && WS_W + 64 * MiB <= WS_GATES && WS_U + (size_t)MT * DFF * 2 <= WS_AB, "d_ws aliases");
constexpr int CW_BAR = 4096;
constexpr int CW_QUEUE = 16384;
constexpr int RING_BYTES = 131072;
constexpr int LDS_BYTES = 147456;
constexpr int MISC_OFF = LDS_BYTES - 256;

#define GAS __attribute__((address_space(1)))
#define LAS __attribute__((address_space(3)))
typedef unsigned short bf16;
typedef unsigned v4u __attribute__((ext_vector_type(4)));
typedef unsigned v2u __attribute__((ext_vector_type(2)));
typedef float f32x4 __attribute__((ext_vector_type(4)));
typedef float f32x2 __attribute__((ext_vector_type(2)));
typedef short bf16x8 __attribute__((ext_vector_type(8)));
typedef short bf16x4 __attribute__((ext_vector_type(4)));
#define LDS_WAIT() asm volatile("s_waitcnt lgkmcnt(0)" ::: "memory")
#define VM_WAIT() asm volatile("s_waitcnt vmcnt(0)" ::: "memory")
__device__ __forceinline__ unsigned pk2(float lo, float hi) { return pg8::cvt_pk_bf16(lo, hi); }
__device__ __forceinline__ float bflo(unsigned w) { return __uint_as_float(w << 16); }
__device__ __forceinline__ float bfhi(unsigned w) { return __uint_as_float(w & 0xffff0000u); }
__device__ __forceinline__ float wave_sum(float v) {
#pragma unroll
    for (int o = 1; o < 64; o <<= 1) v += __shfl_xor(v, o);
    return v;
}
__device__ __forceinline__ float wave_max(float v) {
#pragma unroll
    for (int o = 1; o < 64; o <<= 1) v = fmaxf(v, __shfl_xor(v, o));
    return v;
}
__device__ __forceinline__ float softplusf(float x) { return fmaxf(x, 0.f) + __logf(1.0f + __expf(-fabsf(x))); }
__device__ __forceinline__ f32x4 mfma16(bf16x8 a, bf16x8 b, f32x4 c) { return __builtin_amdgcn_mfma_f32_16x16x32_bf16(a, b, c, 0, 0, 0); }
__device__ __forceinline__ bf16x8 mk8(v2u lo, v2u hi) { v4u w; w.x = lo.x; w.y = lo.y; w.z = hi.x; w.w = hi.y; return __builtin_bit_cast(bf16x8, w); }

#define XB_TMO      128
#define XB_XCNT(j)  (256  + 64 * (j))
#define XB_XSUB(j)  (1280 + 64 * (j))
#define XB_XGEN(j)  (2304 + 64 * (j))
#define XB_TOP      3328
#define XB_TOPGEN   3392
#define XCD_BAR_WORDS 3456
#define XB_SPIN_CAP (1u << 18)
#define LAS __attribute__((address_space(3)))

__device__ __forceinline__ unsigned xb_ld(unsigned* p)              { return __hip_atomic_load(p, __ATOMIC_RELAXED, __HIP_MEMORY_SCOPE_AGENT); }
__device__ __forceinline__ unsigned xb_add(unsigned* p, unsigned v) { return __hip_atomic_fetch_add(p, v, __ATOMIC_RELAXED, __HIP_MEMORY_SCOPE_AGENT); }
__device__ __forceinline__ unsigned xb_xcc_id() { return (unsigned)__builtin_amdgcn_s_getreg((3 << 11) | 20) & 0xFu; }
#define XB_SPIN(cond, bar) do { unsigned _sp = 0; while (cond) { __builtin_amdgcn_s_sleep(1); \
    if ((++_sp & 255u) == 0u) { if (xb_ld(&(bar)[XB_TMO])) break; if (_sp > XB_SPIN_CAP) { atomicAdd(&(bar)[XB_TMO], 1u); break; } } } } while (0)

struct XcdBarrier {
    unsigned* bar; unsigned x;
    volatile LAS unsigned* st;
};

__device__ __forceinline__ XcdBarrier xcd_barrier_post(unsigned* bar, volatile LAS unsigned* st) {
    XcdBarrier b; b.bar = bar; b.x = xb_xcc_id(); b.st = st;
    if (threadIdx.x == 0) (void)xb_add(&bar[XB_XCNT(b.x)], 1u);
    return b;
}
__device__ __forceinline__ void xcd_barrier_complete(unsigned* bar, unsigned x, unsigned& nloc, unsigned& nx) {
    const unsigned G = gridDim.x * gridDim.y * gridDim.z;
    unsigned sum, cnt, mine, sp = 0u;
    for (;;) {
        sum = 0u; cnt = 0u; mine = 0u;
#pragma unroll
        for (unsigned j = 0; j < 16; ++j) { const unsigned c = xb_ld(&bar[XB_XCNT(j)]); sum += c; cnt += (c > 0u) ? 1u : 0u; mine = (j == x) ? c : mine; }
        if (sum == G) break;
        __builtin_amdgcn_s_sleep(1);
        if ((++sp & 255u) == 0u) { if (xb_ld(&bar[XB_TMO])) break; if (sp > XB_SPIN_CAP) { atomicAdd(&bar[XB_TMO], 1u); break; } }
    }
    nloc = mine > 0u ? mine : 1u; nx = cnt > 0u ? cnt : 1u;
}

__device__ __forceinline__ void xcd_barrier(const XcdBarrier& b) {
    asm volatile("s_waitcnt vmcnt(0)" ::: "memory");
    __syncthreads();
    if (threadIdx.x == 0) {
        unsigned* bar = b.bar;
        __builtin_amdgcn_s_waitcnt(0);
        unsigned nloc = b.st[0], nx = b.st[1];
        if (nloc == 0u) { xcd_barrier_complete(bar, b.x, nloc, nx); b.st[0] = nloc; b.st[1] = nx; }
        const unsigned old = xb_add(&bar[XB_XSUB(b.x)], 1u);
        const unsigned gen = old / nloc;
        if (old + 1u == (gen + 1u) * nloc) {
            __builtin_amdgcn_fence(__ATOMIC_RELEASE, "agent");
            asm volatile("s_waitcnt vmcnt(0)" ::: "memory");
            const unsigned og = xb_add(&bar[XB_TOP], 1u);
            const unsigned tg = og / nx;
            if (og + 1u == (tg + 1u) * nx) xb_add(&bar[XB_TOPGEN], 1u);
            else XB_SPIN(xb_ld(&bar[XB_TOPGEN]) == tg, bar);
            __builtin_amdgcn_fence(__ATOMIC_ACQUIRE, "agent");
            xb_add(&bar[XB_XGEN(b.x)], 1u);
            asm volatile("s_waitcnt vmcnt(0)" ::: "memory");
        } else {
            XB_SPIN(xb_ld(&bar[XB_XGEN(b.x)]) == gen, bar);
            __builtin_amdgcn_fence(__ATOMIC_ACQUIRE, "agent");
            asm volatile("s_waitcnt vmcnt(0)" ::: "memory");
        }
    }
    __syncthreads();
}


struct Args { const float* in[19]; float* out; unsigned char* ws; int ph_lo, ph_hi; };

__device__ __forceinline__ void p0_transpose_item(const float* W, int ldw, bf16* WT, int ldt, int dst_row, int src_col, int k0, LAS float* scr, int lane) {
#pragma unroll 8
    for (int i = 0; i < 32; ++i) { const int kk = 2 * i + (lane >> 5); scr[kk * 33 + (lane & 31)] = W[(size_t)(k0 + kk) * ldw + src_col + (lane & 31)]; }
    LDS_WAIT(); asm volatile("" ::: "memory");
    const int c = lane & 7;
#pragma unroll
    for (int j = 0; j < 4; ++j) { const int n = (lane >> 3) + 8 * j; const LAS float* s = scr + (8 * c) * 33 + n;
        v4u o; o.x = pk2(s[0 * 33], s[1 * 33]); o.y = pk2(s[2 * 33], s[3 * 33]); o.z = pk2(s[4 * 33], s[5 * 33]); o.w = pk2(s[6 * 33], s[7 * 33]);
        *(v4u*)(WT + (size_t)(dst_row + n) * ldt + k0 + 8 * c) = o; }
    LDS_WAIT(); asm volatile("" ::: "memory");
}
__device__ __forceinline__ void rms_row_to_bf16(const float* xrow, const float* w, bf16* orow, int lane) {
    unsigned long long* o8 = (unsigned long long*)orow + lane;
    if (xrow == nullptr) {
#pragma unroll
        for (int j = 0; j < 16; ++j) o8[64 * j] = 0ull;
        return; }
    const f32x4* xr = (const f32x4*)xrow + lane; const f32x4* wr = (const f32x4*)w + lane;
    f32x4 v[16]; float s = 0.f;
#pragma unroll
    for (int j = 0; j < 16; ++j) { v[j] = xr[64 * j]; s += (v[j].x * v[j].x + v[j].y * v[j].y) + (v[j].z * v[j].z + v[j].w * v[j].w); }
    const float r = 1.0f / sqrtf(wave_sum(s) * (1.0f / 4096.0f) + 1e-6f);
#pragma unroll
    for (int j = 0; j < 16; ++j) { const f32x4 ww = wr[64 * j]; const f32x4 o = v[j] * r * ww;
        o8[64 * j] = (unsigned long long)pk2(o.x, o.y) | ((unsigned long long)pk2(o.z, o.w) << 32); }
}
__device__ __forceinline__ void rms_row_inplace(float* xrow, const float* w, int lane) {
    f32x4* xr = (f32x4*)xrow + lane; const f32x4* wr = (const f32x4*)w + lane;
    f32x4 v[16]; float s = 0.f;
#pragma unroll
    for (int j = 0; j < 16; ++j) { v[j] = xr[64 * j]; s += (v[j].x * v[j].x + v[j].y * v[j].y) + (v[j].z * v[j].z + v[j].w * v[j].w); }
    const float r = 1.0f / sqrtf(wave_sum(s) * (1.0f / 4096.0f) + 1e-6f);
#pragma unroll
    for (int j = 0; j < 16; ++j) xr[64 * j] = v[j] * r * wr[64 * j];
}
__device__ __forceinline__ void p0_prologue(const Args& a, LAS unsigned char* lds, int G, int tid, int wave, int lane) {
    unsigned char* ws = a.ws;
    LAS float* scr = (LAS float*)(lds + wave * 16384);
    const int gw = (int)blockIdx.x * NWAVES + wave, NGW = G * NWAVES;
    constexpr int I_IN = 641 * 64, I_G = 128 * 32, I_O = 128 * 64, I_UP = 512 * 64, I_DN = 128 * 256, NITEMS = I_IN + 2 * I_G + I_O + I_UP + I_DN;
    for (int it = gw; it < NITEMS; it += NGW) {
        int r = it;
        if (r < I_IN) { const int kb = r / 641, nb = r % 641; const int sc = nb < 192 ? 32 * nb : (nb < 640 ? 32 * nb + 32 : 6144);
            p0_transpose_item(a.in[7], 20512, (bf16*)(ws + WS_WIN), 4096, 32 * nb, sc, 64 * kb, scr, lane); continue; } r -= I_IN;
        if (r < I_G) { p0_transpose_item(a.in[12], 4096, (bf16*)(ws + WS_WGDN), 2048, 32 * (r % 128), 32 * (r % 128), 64 * (r / 128), scr, lane); continue; } r -= I_G;
        if (r < I_G) { p0_transpose_item(a.in[13], 4096, (bf16*)(ws + WS_WSB), 2048, 32 * (r % 128), 32 * (r % 128), 64 * (r / 128), scr, lane); continue; } r -= I_G;
        if (r < I_O) { p0_transpose_item(a.in[14], 4096, (bf16*)(ws + WS_WOUT), 4096, 32 * (r % 128), 32 * (r % 128), 64 * (r / 128), scr, lane); continue; } r -= I_O;
        if (r < I_UP) { p0_transpose_item(a.in[16], 16384, (bf16*)(ws + WS_WUP), 4096, 32 * (r % 512), 32 * (r % 512), 64 * (r / 512), scr, lane); continue; } r -= I_UP;
        p0_transpose_item(a.in[17], 4096, (bf16*)(ws + WS_WDOWN), 16384, 32 * (r % 128), 32 * (r % 128), 64 * (r / 128), scr, lane);
    }
    { v4u* zp = (v4u*)(ws + WS_WIN + (size_t)20512 * 4096 * 2); const int nz = 224 * 4096 * 2 / 16; const v4u z4 = {0u, 0u, 0u, 0u};
      for (int i = (int)blockIdx.x * (NWAVES * 64) + tid; i < nz; i += G * NWAVES * 64) zp[i] = z4; }
    bf16* XN = (bf16*)(ws + WS_XN);
    for (int m = gw; m < MT; m += NGW) {
        const float* xr = m < PROWS ? a.in[0] + (size_t)m * D : (m < REALROWS ? a.in[1] + (size_t)(m - PROWS) * D : nullptr);
        rms_row_to_bf16(xr, a.in[6], XN + (size_t)m * D, lane); }
}

template <int KIND, bool SAMPLE>
__device__ __forceinline__ void conv_unit(const Args& a, int c, int j, int lane) {
    constexpr int NT = SAMPLE ? 16 : 64;
    unsigned char* ws = a.ws;
    const int ch = (KIND == 0 ? 0 : (KIND == 1 ? 1024 : 2048)) + 128 * j + 2 * lane;
    const int row0 = SAMPLE ? PROWS + 16 * c : 64 * c;
    const bf16* raw = (const bf16*)(ws + WS_QKVRAW);
    const float* cw = a.in[8] + ch;
    const f32x2 w0 = *(const f32x2*)(cw), w1 = *(const f32x2*)(cw + 4096), w2 = *(const f32x2*)(cw + 8192), w3 = *(const f32x2*)(cw + 12288);
    f32x2 xm3 = {0.f, 0.f}, xm2 = {0.f, 0.f}, xm1 = {0.f, 0.f};
    if (SAMPLE) { const float* past = a.in[5] + (size_t)c * 3 * 4096 + ch; xm3 = *(const f32x2*)(past); xm2 = *(const f32x2*)(past + 4096); xm1 = *(const f32x2*)(past + 8192); }
    else if (c > 0) { const unsigned p3 = *(const unsigned*)(raw + (size_t)(row0 - 3) * 4096 + ch), p2 = *(const unsigned*)(raw + (size_t)(row0 - 2) * 4096 + ch), p1 = *(const unsigned*)(raw + (size_t)(row0 - 1) * 4096 + ch);
        xm3 = (f32x2){bflo(p3), bfhi(p3)}; xm2 = (f32x2){bflo(p2), bfhi(p2)}; xm1 = (f32x2){bflo(p1), bfhi(p1)}; }
    unsigned tp0[NT / 2], tp1[NT / 2];
#pragma unroll
    for (int t = 0; t < NT; ++t) {
        const unsigned xw = *(const unsigned*)(raw + (size_t)(row0 + t) * 4096 + ch);
        const f32x2 xt = {bflo(xw), bfhi(xw)};
        f32x2 y = w0 * xm3 + w1 * xm2 + w2 * xm1 + w3 * xt;
        xm3 = xm2; xm2 = xm1; xm1 = xt;
        y.x = y.x * __builtin_amdgcn_rcpf(1.0f + __expf(-y.x)); y.y = y.y * __builtin_amdgcn_rcpf(1.0f + __expf(-y.y));
        if (KIND < 2) { const float ss = wave_sum(y.x * y.x + y.y * y.y); const float sc = (1.0f / sqrtf(ss + 1e-6f)) * (KIND == 0 ? 0.08838834764831845f : 1.0f); y = y * sc; }
        if (SAMPLE) {
            float* dst = (float*)(ws + WS_SMP) + (KIND == 0 ? 0 : (KIND == 1 ? 128 * 1024 : 256 * 1024));
            const int ld = KIND == 2 ? 2048 : 1024;
            *(f32x2*)(dst + (size_t)(16 * c + t) * ld + 128 * j + 2 * lane) = y;
        } else {
            const unsigned pk = pk2(y.x, y.y);
            if (KIND == 0) *(unsigned*)((bf16*)(ws + WS_GQ) + (size_t)(row0 + t) * 1024 + 128 * j + 2 * lane) = pk;
            if (KIND == 1) *(unsigned*)((bf16*)(ws + WS_GK) + (size_t)(row0 + t) * 1024 + 128 * j + 2 * lane) = pk;
            if (KIND >= 1) { if ((t & 1) == 0) { tp0[t / 2] = pk & 0xffffu; tp1[t / 2] = pk >> 16; } else { tp0[t / 2] |= pk << 16; tp1[t / 2] |= pk & 0xffff0000u; } }
        }
    }
    if (!SAMPLE && KIND >= 1) {
        bf16* tb = (KIND == 1) ? (bf16*)(ws + WS_KT) + ((size_t)(c * 8 + j) * 128 + 2 * lane) * 64 : (bf16*)(ws + WS_GVT) + ((size_t)(c * 16 + j) * 128 + 2 * lane) * 64;
#pragma unroll
        for (int q = 0; q < NT / 8; ++q) {
            *(v4u*)(tb + 8 * q) = (v4u){tp0[4 * q], tp0[4 * q + 1], tp0[4 * q + 2], tp0[4 * q + 3]};
            *(v4u*)(tb + 64 + 8 * q) = (v4u){tp1[4 * q], tp1[4 * q + 1], tp1[4 * q + 2], tp1[4 * q + 3]}; }
    }
}
__device__ __forceinline__ void p2_conv(const Args& a, int G, int tid, int wave, int lane) {
    const int gw = (int)blockIdx.x * NWAVES + wave, NGW = G * NWAVES;
    for (int it = gw; it < 8192 + 256; it += NGW) {
        if (it < 8192) { const int c = it >> 5, j = it & 31;
            if (j < 8) conv_unit<0, false>(a, c, j, lane); else if (j < 16) conv_unit<1, false>(a, c, j - 8, lane); else conv_unit<2, false>(a, c, j - 16, lane);
        } else { const int c = (it - 8192) >> 5, j = it & 31;
            if (j < 8) conv_unit<0, true>(a, c, j, lane); else if (j < 16) conv_unit<1, true>(a, c, j - 8, lane); else conv_unit<2, true>(a, c, j - 16, lane); }
    }
    const float* ab = (const float*)(a.ws + WS_AB); float* gb = (float*)(a.ws + WS_GB);
    for (int i = (int)blockIdx.x * (NWAVES * 64) + tid; i < REALROWS * 16; i += G * NWAVES * 64) { const int m = i >> 4, h = i & 15;
        const float av = ab[(size_t)m * 32 + h], bv = ab[(size_t)m * 32 + 16 + h];
        gb[(size_t)m * 32 + h] = -__expf(a.in[9][h]) * softplusf(av + a.in[10][h]);
        gb[(size_t)m * 32 + 16 + h] = 1.0f / (1.0f + __expf(-bv)); }
}

constexpr int PREP_MP = 68, PREP_WL = 64 * PREP_MP * 4 + 768;
__device__ __forceinline__ void gdn_prep_unit(const Args& a, int c, int h, LAS unsigned char* wl, int lane) {
    unsigned char* ws = a.ws;
    const int hq = h >> 1, tok0 = 64 * c, unit = c * 16 + h, i16 = lane & 15, g = lane >> 4;
    LAS float* Mx = (LAS float*)wl;
    LAS float* s_gc = (LAS float*)(wl + 64 * PREP_MP * 4); LAS float* s_bt = s_gc + 64; LAS float* s_bg = s_gc + 128;
    const float* gb = (const float*)(ws + WS_GB);
    const float gt = gb[(size_t)(tok0 + lane) * 32 + h], bt = gb[(size_t)(tok0 + lane) * 32 + 16 + h];
    float gc = gt;
#pragma unroll
    for (int o = 1; o < 64; o <<= 1) { const float t = __shfl_up(gc, o); if (lane >= o) gc += t; }
    const float gl = __shfl(gc, 63);
    const float egc = __expf(gc);
    s_gc[lane] = gc; s_bt[lane] = bt; s_bg[lane] = bt * egc;
    { float* ev = (float*)(ws + WS_EV) + (size_t)unit * 128; ev[lane] = egc; ev[64 + lane] = __expf(gl - gc); }
    LDS_WAIT(); asm volatile("" ::: "memory");
    const bf16* GK = (const bf16*)(ws + WS_GK) + (size_t)tok0 * 1024 + hq * 128 + 8 * g; const bf16* GQ = (const bf16*)(ws + WS_GQ) + (size_t)tok0 * 1024 + hq * 128 + 8 * g;
#pragma unroll 1
    for (int I = 0; I < 4; ++I) {
        bf16x8 kI[4];
#pragma unroll
        for (int s = 0; s < 4; ++s) kI[s] = *(const bf16x8*)(GK + (size_t)(16 * I + i16) * 1024 + 32 * s);
        const f32x4 gci = *(const LAS f32x4*)(s_gc + 16 * I + 4 * g), bti = *(const LAS f32x4*)(s_bt + 16 * I + 4 * g);
#pragma unroll 1
        for (int J = 0; J <= I; ++J) {
            f32x4 acc = {0.f, 0.f, 0.f, 0.f};
#pragma unroll
            for (int s = 0; s < 4; ++s) acc = mfma16(kI[s], *(const bf16x8*)(GK + (size_t)(16 * J + i16) * 1024 + 32 * s), acc);
            const int jj = 16 * J + i16; const float gcj = s_gc[jj];
            f32x4 l4;
#pragma unroll
            for (int r = 0; r < 4; ++r) { const int ii = 16 * I + 4 * g + r; l4[r] = (ii > jj) ? bti[r] * acc[r] * __expf(gci[r] - gcj) : 0.f; }
            *(LAS f32x4*)(Mx + jj * PREP_MP + 16 * I + 4 * g) = l4;
        }
    }
    bf16* AQK = (bf16*)(ws + WS_AQK) + (size_t)unit * 4096;
#pragma unroll 1
    for (int I = 0; I < 4; ++I) {
        bf16x8 qf[4];
#pragma unroll
        for (int s = 0; s < 4; ++s) qf[s] = *(const bf16x8*)(GQ + (size_t)(16 * I + i16) * 1024 + 32 * s);
        const int ii = 16 * I + i16; const float gci = s_gc[ii];
#pragma unroll 1
        for (int J = 0; J < 4; ++J) {
            v2u o = {0u, 0u};
            if (J <= I) {
                f32x4 acc = {0.f, 0.f, 0.f, 0.f};
#pragma unroll
                for (int s = 0; s < 4; ++s) acc = mfma16(*(const bf16x8*)(GK + (size_t)(16 * J + i16) * 1024 + 32 * s), qf[s], acc);
                const f32x4 gcj = *(const LAS f32x4*)(s_gc + 16 * J + 4 * g);
                f32x4 v;
#pragma unroll
                for (int r = 0; r < 4; ++r) { const int jj = 16 * J + 4 * g + r; v[r] = (ii >= jj) ? acc[r] * __expf(gci - gcj[r]) : 0.f; }
                o.x = pk2(v[0], v[1]); o.y = pk2(v[2], v[3]);
            }
            *(v2u*)(AQK + (size_t)ii * 64 + 16 * J + 4 * g) = o;
        }
    }
    LDS_WAIT(); asm volatile("" ::: "memory");
#pragma unroll 1
    for (int c2 = 63; c2 >= 0; --c2) {
        float s0 = (lane == c2) ? 1.f : 0.f, s1 = 0.f;
        const LAS float* lrow = Mx + c2 * PREP_MP;
        const LAS float* trow = Mx + lane * PREP_MP;
#pragma unroll 2
        for (int j0 = ((c2 + 1) >> 2) << 2; j0 < 64; j0 += 4) {
            const f32x4 l4 = *(const LAS f32x4*)(lrow + j0), t4 = *(const LAS f32x4*)(trow + j0);
#pragma unroll
            for (int e = 0; e < 4; ++e) { const int j = j0 + e; const float p = (j > c2 && j <= lane) ? t4[e] * l4[e] : 0.f; if (e & 1) s1 -= p; else s0 -= p; }
        }
        if (c2 <= lane) Mx[lane * PREP_MP + c2] = s0 + s1;
        LDS_WAIT(); asm volatile("" ::: "memory");
    }
    bf16x8 tf[4][2];
#pragma unroll
    for (int I = 0; I < 4; ++I)
#pragma unroll
        for (int s = 0; s < 2; ++s) if (s == 0 || I >= 2) { const int ii = 16 * I + i16, j0 = 32 * s + 8 * g;
            const f32x4 a0 = *(const LAS f32x4*)(Mx + ii * PREP_MP + j0), a1 = *(const LAS f32x4*)(Mx + ii * PREP_MP + j0 + 4);
            float v[8];
#pragma unroll
            for (int e = 0; e < 4; ++e) { v[e] = (j0 + e <= ii) ? a0[e] : 0.f; v[4 + e] = (j0 + 4 + e <= ii) ? a1[e] : 0.f; }
            v4u w; w.x = pk2(v[0], v[1]); w.y = pk2(v[2], v[3]); w.z = pk2(v[4], v[5]); w.w = pk2(v[6], v[7]);
            tf[I][s] = __builtin_bit_cast(bf16x8, w); }
    const bf16* GVT = (const bf16*)(ws + WS_GVT) + (size_t)unit * 128 * 64;
    v2u* U0F = (v2u*)(ws + WS_U0F) + (size_t)unit * 8 * 4 * 64;
#pragma unroll 1
    for (int N = 0; N < 8; ++N) {
        bf16x8 vb[2];
#pragma unroll
        for (int s = 0; s < 2; ++s) { const v4u w = *(const v4u*)(GVT + (size_t)(16 * N + i16) * 64 + 32 * s + 8 * g);
            const f32x4 b0 = *(const LAS f32x4*)(s_bt + 32 * s + 8 * g), b1 = *(const LAS f32x4*)(s_bt + 32 * s + 8 * g + 4);
            v4u o; o.x = pk2(bflo(w.x) * b0[0], bfhi(w.x) * b0[1]); o.y = pk2(bflo(w.y) * b0[2], bfhi(w.y) * b0[3]); o.z = pk2(bflo(w.z) * b1[0], bfhi(w.z) * b1[1]); o.w = pk2(bflo(w.w) * b1[2], bfhi(w.w) * b1[3]);
            vb[s] = __builtin_bit_cast(bf16x8, o); }
#pragma unroll
        for (int I = 0; I < 4; ++I) {
            f32x4 acc = {0.f, 0.f, 0.f, 0.f};
            acc = mfma16(tf[I][0], vb[0], acc);
            if (I >= 2) acc = mfma16(tf[I][1], vb[1], acc);
            U0F[(N * 4 + I) * 64 + lane] = (v2u){pk2(acc[0], acc[1]), pk2(acc[2], acc[3])};
        }
    }
    const bf16* KT = (const bf16*)(ws + WS_KT) + (size_t)(c * 8 + hq) * 128 * 64;
    bf16* Wo = (bf16*)(ws + WS_W) + (size_t)unit * 64 * 128;
#pragma unroll 1
    for (int Dt = 0; Dt < 8; ++Dt) {
        bf16x8 ka[2];
#pragma unroll
        for (int s = 0; s < 2; ++s) { const v4u w = *(const v4u*)(KT + (size_t)(16 * Dt + i16) * 64 + 32 * s + 8 * g);
            const f32x4 b0 = *(const LAS f32x4*)(s_bg + 32 * s + 8 * g), b1 = *(const LAS f32x4*)(s_bg + 32 * s + 8 * g + 4);
            v4u o; o.x = pk2(bflo(w.x) * b0[0], bfhi(w.x) * b0[1]); o.y = pk2(bflo(w.y) * b0[2], bfhi(w.y) * b0[3]); o.z = pk2(bflo(w.z) * b1[0], bfhi(w.z) * b1[1]); o.w = pk2(bflo(w.w) * b1[2], bfhi(w.w) * b1[3]);
            ka[s] = __builtin_bit_cast(bf16x8, o); }
#pragma unroll
        for (int I = 0; I < 4; ++I) {
            f32x4 acc = {0.f, 0.f, 0.f, 0.f};
            acc = mfma16(ka[0], tf[I][0], acc);
            if (I >= 2) acc = mfma16(ka[1], tf[I][1], acc);
            *(v2u*)(Wo + (size_t)(16 * I + i16) * 128 + 16 * Dt + 4 * g) = (v2u){pk2(acc[0], acc[1]), pk2(acc[2], acc[3])};
        }
    }
    LDS_WAIT(); asm volatile("" ::: "memory");
}

constexpr int SC_W = 0, SC_Q = 17408, SC_KT = 34816, SC_AQ = 53248, SC_EV = 62464, SC_BUF = 62976, SC_OB = 2 * SC_BUF;
static_assert(SC_OB + 2 * 8192 <= MISC_OFF, "scan LDS");
__device__ __forceinline__ void gdn_scan_wg(const Args& a, int sw, LAS unsigned char* lds, int tid, int wave, int lane) {
    unsigned char* ws = a.ws;
    const int h = sw >> 1, H = sw & 1, hq = h >> 1, i16 = lane & 15, g = lane >> 4;
    const bool loader = wave >= 4; const int lt = tid - 256;
    const bf16* Wg = (const bf16*)(ws + WS_W); const bf16* GQ = (const bf16*)(ws + WS_GQ); const bf16* KTg = (const bf16*)(ws + WS_KT);
    const bf16* AQg = (const bf16*)(ws + WS_AQK); const float* EVg = (const float*)(ws + WS_EV);
    const v2u* U0F = (const v2u*)(ws + WS_U0F); bf16* OA = (bf16*)(ws + WS_OA);
    const int N = 4 * H + (wave & 3);
    f32x4 S[8];
#pragma unroll
    for (int d = 0; d < 8; ++d) S[d] = (f32x4){0.f, 0.f, 0.f, 0.f};
    v2u u0c[4] = {{0u, 0u}, {0u, 0u}, {0u, 0u}, {0u, 0u}};
#define SCAN_STAGE(cc) do { const int _c = (cc); const int _unit = _c * 16 + h; LAS unsigned char* _b = lds + (_c & 1) * SC_BUF; v4u _r[15]; \
        _Pragma("unroll") for (int k = 0; k < 4; ++k) { const int q = lt + 256 * k; _r[k] = *(const v4u*)(Wg + (size_t)_unit * 8192 + q * 8); } \
        _Pragma("unroll") for (int k = 0; k < 4; ++k) { const int q = lt + 256 * k; _r[4 + k] = *(const v4u*)(GQ + (size_t)(64 * _c + (q >> 4)) * 1024 + hq * 128 + (q & 15) * 8); } \
        _Pragma("unroll") for (int k = 0; k < 4; ++k) { const int q = lt + 256 * k; _r[8 + k] = *(const v4u*)(KTg + (size_t)(_c * 8 + hq) * 8192 + q * 8); } \
        _Pragma("unroll") for (int k = 0; k < 2; ++k) { const int q = lt + 256 * k; _r[12 + k] = *(const v4u*)(AQg + (size_t)_unit * 4096 + q * 8); } \
        if (lt < 32) _r[14] = *(const v4u*)(EVg + (size_t)_unit * 128 + lt * 4); \
        _Pragma("unroll") for (int k = 0; k < 4; ++k) { const int q = lt + 256 * k; *(LAS v4u*)(_b + SC_W + (q >> 4) * 272 + (q & 15) * 16) = _r[k]; } \
        _Pragma("unroll") for (int k = 0; k < 4; ++k) { const int q = lt + 256 * k; *(LAS v4u*)(_b + SC_Q + (q >> 4) * 272 + (q & 15) * 16) = _r[4 + k]; } \
        _Pragma("unroll") for (int k = 0; k < 4; ++k) { const int q = lt + 256 * k; *(LAS v4u*)(_b + SC_KT + (q >> 3) * 144 + (q & 7) * 16) = _r[8 + k]; } \
        _Pragma("unroll") for (int k = 0; k < 2; ++k) { const int q = lt + 256 * k; *(LAS v4u*)(_b + SC_AQ + (q >> 3) * 144 + (q & 7) * 16) = _r[12 + k]; } \
        if (lt < 32) *(LAS v4u*)(_b + SC_EV + lt * 16) = _r[14]; } while (0)
#define SCAN_OUT(cc) do { const int _c = (cc); LAS unsigned char* _ob = lds + SC_OB + (_c & 1) * 8192; \
        _Pragma("unroll") for (int k = 0; k < 2; ++k) { const int q = lt + 256 * k; const v4u v = *(const LAS v4u*)(_ob + (q >> 3) * 128 + (q & 7) * 16); \
            *(v4u*)(OA + (size_t)(64 * _c + (q >> 3)) * 2048 + h * 128 + 64 * H + (q & 7) * 8) = v; } } while (0)
    if (loader) { SCAN_STAGE(0); }
    else {
#pragma unroll
        for (int I = 0; I < 4; ++I) u0c[I] = U0F[((size_t)(0 * 16 + h) * 8 + N) * 256 + I * 64 + lane];
    }
    LDS_WAIT(); __syncthreads();
    for (int c = 0; c < 256; ++c) {
        if (loader) {
            if (c + 1 < 256) SCAN_STAGE(c + 1);
            if (c >= 1) SCAN_OUT(c - 1);
        } else {
            LAS unsigned char* b = lds + (c & 1) * SC_BUF;
            v2u u0n[4] = {{0u, 0u}, {0u, 0u}, {0u, 0u}, {0u, 0u}};
            if (c + 1 < 256) {
#pragma unroll
                for (int I = 0; I < 4; ++I) u0n[I] = U0F[((size_t)((c + 1) * 16 + h) * 8 + N) * 256 + I * 64 + lane];
            }
            const float egl = *(const LAS float*)(b + SC_EV + 63 * 4);
            v2u Sb[8];
#pragma unroll
            for (int d = 0; d < 8; ++d) { Sb[d] = (v2u){pk2(S[d][0], S[d][1]), pk2(S[d][2], S[d][3])}; S[d] = S[d] * egl; }
            f32x4 aw[4], aq[4];
#pragma unroll
            for (int I = 0; I < 4; ++I) { aw[I] = (f32x4){0.f, 0.f, 0.f, 0.f}; aq[I] = (f32x4){0.f, 0.f, 0.f, 0.f}; }
#pragma unroll
            for (int s = 0; s < 4; ++s) { const bf16x8 Bf = mk8(Sb[2 * s], Sb[2 * s + 1]);
#pragma unroll
                for (int I = 0; I < 4; ++I) {
                    const LAS unsigned char* pw = b + SC_W + (16 * I + i16) * 272 + (32 * s + 4 * g) * 2;
                    const LAS unsigned char* pq = b + SC_Q + (16 * I + i16) * 272 + (32 * s + 4 * g) * 2;
                    aw[I] = mfma16(mk8(*(const LAS v2u*)pw, *(const LAS v2u*)(pw + 32)), Bf, aw[I]);
                    aq[I] = mfma16(mk8(*(const LAS v2u*)pq, *(const LAS v2u*)(pq + 32)), Bf, aq[I]); } }
            v2u ub[4], ubk[4]; f32x4 o[4];
#pragma unroll
            for (int I = 0; I < 4; ++I) {
                const f32x4 eg4 = *(const LAS f32x4*)(b + SC_EV + (16 * I + 4 * g) * 4), ek4 = *(const LAS f32x4*)(b + SC_EV + 256 + (16 * I + 4 * g) * 4);
                f32x4 u; u[0] = bflo(u0c[I].x) - aw[I][0]; u[1] = bfhi(u0c[I].x) - aw[I][1]; u[2] = bflo(u0c[I].y) - aw[I][2]; u[3] = bfhi(u0c[I].y) - aw[I][3];
                ub[I] = (v2u){pk2(u[0], u[1]), pk2(u[2], u[3])};
                const f32x4 uk = u * ek4; ubk[I] = (v2u){pk2(uk[0], uk[1]), pk2(uk[2], uk[3])};
                o[I] = aq[I] * eg4; }
#pragma unroll
            for (int I = 0; I < 4; ++I)
#pragma unroll
                for (int sp = 0; sp < 2; ++sp) if (sp == 0 || I >= 2) {
                    const LAS unsigned char* pa = b + SC_AQ + (16 * I + i16) * 144 + (32 * sp + 4 * g) * 2;
                    o[I] = mfma16(mk8(*(const LAS v2u*)pa, *(const LAS v2u*)(pa + 32)), mk8(ub[2 * sp], ub[2 * sp + 1]), o[I]); }
            { LAS unsigned char* ob = lds + SC_OB + (c & 1) * 8192;
#pragma unroll
              for (int I = 0; I < 4; ++I)
#pragma unroll
                  for (int r = 0; r < 4; ++r) *(LAS unsigned short*)(ob + (16 * I + 4 * g + r) * 128 + (16 * (wave & 3) + i16) * 2) = (unsigned short)(pk2(o[I][r], 0.f) & 0xffffu); }
#pragma unroll
            for (int d = 0; d < 8; ++d)
#pragma unroll
                for (int sp = 0; sp < 2; ++sp) {
                    const LAS unsigned char* pk = b + SC_KT + (16 * d + i16) * 144 + (32 * sp + 4 * g) * 2;
                    S[d] = mfma16(mk8(*(const LAS v2u*)pk, *(const LAS v2u*)(pk + 32)), mk8(ubk[2 * sp], ubk[2 * sp + 1]), S[d]); }
#pragma unroll
            for (int I = 0; I < 4; ++I) u0c[I] = u0n[I];
        }
        LDS_WAIT(); __syncthreads();
    }
    if (loader) { SCAN_OUT(255); }
    else {
        float* So = a.out + pg8::O_SP + (size_t)h * 128 * 128;
#pragma unroll
        for (int d = 0; d < 8; ++d)
#pragma unroll
            for (int r = 0; r < 4; ++r) So[(size_t)(16 * d + 4 * g + r) * 128 + 16 * N + i16] = S[d][r];
    }
    LDS_WAIT(); __syncthreads();
#undef SCAN_STAGE
#undef SCAN_OUT
}

__device__ __forceinline__ void gdn_sample_unit(const Args& a, int b, int h, LAS unsigned char* lds, int tid) {
    unsigned char* ws = a.ws;
    const int dv = tid & 127, dq = tid >> 7, hq = h >> 1;
    LAS float* kq = (LAS float*)lds;
    LAS float* red = kq + 256;
    const float* S0 = a.in[4] + ((size_t)(b * 16 + h) * 128) * 128;
    float s[32];
#pragma unroll
    for (int i = 0; i < 32; ++i) s[i] = S0[(size_t)(dq * 32 + i) * 128 + dv];
    const float* SQ = (const float*)(ws + WS_SMP); const float* SK = SQ + 128 * 1024; const float* SV = SQ + 256 * 1024;
    const float* gb = (const float*)(ws + WS_GB);
    bf16* OA = (bf16*)(ws + WS_OA);
    for (int t = 0; t < 16; ++t) {
        const int row = 16 * b + t;
        __syncthreads();
        if (tid < 128) kq[tid] = SK[(size_t)row * 1024 + hq * 128 + tid]; else if (tid < 256) kq[tid] = SQ[(size_t)row * 1024 + hq * 128 + tid - 128];
        const float vt = SV[(size_t)row * 2048 + h * 128 + dv];
        const float al = __expf(gb[(size_t)(PROWS + row) * 32 + h]), be = gb[(size_t)(PROWS + row) * 32 + 16 + h];
        __syncthreads();
        float p = 0.f;
#pragma unroll
        for (int i = 0; i < 32; ++i) p += kq[dq * 32 + i] * s[i];
        red[dq * 128 + dv] = p;
        __syncthreads();
        const float rr = (red[dv] + red[128 + dv]) + (red[256 + dv] + red[384 + dv]);
        const float delta = be * (vt - al * rr);
        float po = 0.f;
#pragma unroll
        for (int i = 0; i < 32; ++i) { s[i] = al * s[i] + kq[dq * 32 + i] * delta; po += kq[128 + dq * 32 + i] * s[i]; }
        __syncthreads();
        red[dq * 128 + dv] = po;
        __syncthreads();
        if (dq == 0) { const float ov = (red[dv] + red[128 + dv]) + (red[256 + dv] + red[384 + dv]);
            OA[(size_t)(PROWS + row) * 2048 + h * 128 + dv] = (bf16)(pk2(ov, 0.f) & 0xffffu); }
    }
    float* So = a.out + pg8::O_SS + ((size_t)(b * 16 + h) * 128) * 128;
#pragma unroll
    for (int i = 0; i < 32; ++i) So[(size_t)(dq * 32 + i) * 128 + dv] = s[i];
    __syncthreads();
}

constexpr int AT_K = 0, AT_V = 64 * 272, AT_WM = AT_V + 64 * 288;
constexpr int PAST = 2048;
typedef short s16x4 __attribute__((ext_vector_type(4)));
template <bool SAMPLE>
__device__ __forceinline__ void attn_unit(const Args& a, int qb, int hh, LAS unsigned char* lds, int tid, int wave, int lane) {
    unsigned char* ws = a.ws;
    const int i16 = lane & 15, g = lane >> 4;
    const bf16* QSB = (const bf16*)(ws + WS_QSB); const bf16* KSB = (const bf16*)(ws + WS_KSB); const bf16* VSB = (const bf16*)(ws + WS_VSB); bf16* OB = (bf16*)(ws + WS_OB);
    const bool wvalid = !SAMPLE || wave == 0;
    const int qrow = SAMPLE ? PROWS + 16 * qb + i16 : 128 * qb + 16 * wave + i16;
    const int qpos = SAMPLE ? (wvalid ? PAST + i16 : -1) : qrow;
    bf16x8 qf[4];
#pragma unroll
    for (int s = 0; s < 4; ++s) qf[s] = *(const bf16x8*)(QSB + (size_t)qrow * 2048 + hh * 128 + 32 * s + 8 * g);
    float carry = 0.f;
    f32x4 oacc[8];
#pragma unroll
    for (int d = 0; d < 8; ++d) oacc[d] = (f32x4){0.f, 0.f, 0.f, 0.f};
    const int kb_hi = SAMPLE ? 32 : 2 * qb + 1;
    LAS float* wm = (LAS float*)(lds + AT_WM);
    for (int kb = kb_hi; kb >= 0; --kb) {
        if (kb != kb_hi) { const float m = wave_max(wvalid ? carry : -1e30f); if (lane == 0) wm[wave] = m; }
        LDS_WAIT(); __syncthreads();
        if (kb != kb_hi) { float m = wm[0];
#pragma unroll
            for (int w = 1; w < 8; ++w) m = fmaxf(m, wm[w]);
            if (m < -104.f) break; }
#pragma unroll
        for (int k = 0; k < 2; ++k) { const int q = tid + 512 * k, row = q >> 4, cc = q & 15; v4u kv, vv;
            if (!SAMPLE) { const size_t off = (size_t)(64 * kb + row) * 2048 + hh * 128 + cc * 8; kv = *(const v4u*)(KSB + off); vv = *(const v4u*)(VSB + off); }
            else { const int pos = 64 * kb + row;
                if (pos < PAST) { const size_t off = (((size_t)qb * PAST + pos) * 16 + hh) * 128 + cc * 8; const f32x4 k0 = *(const f32x4*)(a.in[2] + off), k1 = *(const f32x4*)(a.in[2] + off + 4), v0 = *(const f32x4*)(a.in[3] + off), v1 = *(const f32x4*)(a.in[3] + off + 4);
                    kv = (v4u){pk2(k0[0], k0[1]), pk2(k0[2], k0[3]), pk2(k1[0], k1[1]), pk2(k1[2], k1[3])}; vv = (v4u){pk2(v0[0], v0[1]), pk2(v0[2], v0[3]), pk2(v1[0], v1[1]), pk2(v1[2], v1[3])}; }
                else if (pos < PAST + 16) { const size_t off = (size_t)(PROWS + 16 * qb + pos - PAST) * 2048 + hh * 128 + cc * 8; kv = *(const v4u*)(KSB + off); vv = *(const v4u*)(VSB + off); }
                else { kv = (v4u){0u, 0u, 0u, 0u}; vv = kv; } }
            *(LAS v4u*)(lds + AT_K + row * 272 + cc * 16) = kv; *(LAS v4u*)(lds + AT_V + row * 288 + cc * 16) = vv; }
        LDS_WAIT(); __syncthreads();
        f32x4 z[4];
#pragma unroll
        for (int T = 0; T < 4; ++T) { z[T] = (f32x4){0.f, 0.f, 0.f, 0.f};
#pragma unroll
            for (int s = 0; s < 4; ++s) z[T] = mfma16(*(const LAS bf16x8*)(lds + AT_K + (16 * T + i16) * 272 + (32 * s + 8 * g) * 2), qf[s], z[T]); }
        float run = carry; v2u pb[4];
#pragma unroll
        for (int T = 3; T >= 0; --T) {
            float lf[4], ls[4]; bool vd[4];
#pragma unroll
            for (int r = 0; r < 4; ++r) { const int kpos = 64 * kb + 16 * T + 4 * g + r; vd[r] = kpos < qpos; const float zz = z[T][r] * 0.08838834764831845f; const float sp = softplusf(zz);
                lf[r] = vd[r] ? -sp : 0.f; ls[r] = zz - sp; }
            const float G = (lf[0] + lf[1]) + (lf[2] + lf[3]);
            const float G1 = __shfl_xor(G, 16), G2 = __shfl_xor(G, 32), G3 = __shfl_xor(G, 48);
            const float above = (g == 0) ? (G1 + G2 + G3) : ((g == 1) ? (G2 + G3) : ((g == 2) ? G1 : 0.f));
            const float t3 = run + above, t2 = t3 + lf[3], t1 = t2 + lf[2], t0 = t1 + lf[1];
            const float a0 = vd[0] ? __expf(ls[0] + t0) : 0.f, a1 = vd[1] ? __expf(ls[1] + t1) : 0.f, a2 = vd[2] ? __expf(ls[2] + t2) : 0.f, a3 = vd[3] ? __expf(ls[3] + t3) : 0.f;
            pb[T] = (v2u){pk2(a0, a1), pk2(a2, a3)};
            run += (G + G1) + (G2 + G3);
        }
        carry = run;
        const int q4 = i16 >> 2, p4 = i16 & 3;
#pragma unroll
        for (int sp = 0; sp < 2; ++sp) { const bf16x8 Bf = mk8(pb[2 * sp], pb[2 * sp + 1]);
#pragma unroll
            for (int d = 0; d < 8; ++d) {
                LAS unsigned char* p0 = lds + AT_V + (32 * sp + 4 * g + q4) * 288 + (16 * d + 4 * p4) * 2;
                const s16x4 a0 = __builtin_amdgcn_ds_read_tr16_b64_v4i16((LAS s16x4*)p0), a1 = __builtin_amdgcn_ds_read_tr16_b64_v4i16((LAS s16x4*)(p0 + 16 * 288));
                bf16x8 Af; Af[0] = a0[0]; Af[1] = a0[1]; Af[2] = a0[2]; Af[3] = a0[3]; Af[4] = a1[0]; Af[5] = a1[1]; Af[6] = a1[2]; Af[7] = a1[3];
                oacc[d] = mfma16(Af, Bf, oacc[d]); } }
    }
    if (wvalid) {
#pragma unroll
        for (int d = 0; d < 8; ++d) *(v2u*)(OB + (size_t)qrow * 2048 + hh * 128 + 16 * d + 4 * g) = (v2u){pk2(oacc[d][0], oacc[d][1]), pk2(oacc[d][2], oacc[d][3])};
    }
    LDS_WAIT(); __syncthreads();
}

__device__ __forceinline__ void p5_oanorm(const Args& a, int G, int wave, int lane) {
    unsigned char* ws = a.ws; bf16* OA = (bf16*)(ws + WS_OA); const bf16* Z = (const bf16*)(ws + WS_Z);
    const int gw = (int)blockIdx.x * NWAVES + wave, NGW = G * NWAVES;
    const int c8 = (lane & 15) * 8;
    const f32x4 w0 = *(const f32x4*)(a.in[11] + c8), w1 = *(const f32x4*)(a.in[11] + c8 + 4);
    for (int it = gw; it < REALROWS * 4; it += NGW) { const int m = it >> 2, hd = (it & 3) * 4 + (lane >> 4);
        const size_t off = (size_t)m * 2048 + hd * 128 + c8;
        f32x4 o0, o1, z0, z1; pg8::unpack8(*(const v4u*)(OA + off), o0, o1); pg8::unpack8(*(const v4u*)(Z + off), z0, z1);
        float ss = (o0[0] * o0[0] + o0[1] * o0[1]) + (o0[2] * o0[2] + o0[3] * o0[3]) + (o1[0] * o1[0] + o1[1] * o1[1]) + (o1[2] * o1[2] + o1[3] * o1[3]);
        ss += __shfl_xor(ss, 1); ss += __shfl_xor(ss, 2); ss += __shfl_xor(ss, 4); ss += __shfl_xor(ss, 8);
        const float r = 1.0f / sqrtf(ss * (1.0f / 128.0f) + 1e-6f);
#pragma unroll
        for (int j = 0; j < 4; ++j) { o0[j] = o0[j] * r * w0[j] * (z0[j] * __builtin_amdgcn_rcpf(1.0f + __expf(-z0[j]))); o1[j] = o1[j] * r * w1[j] * (z1[j] * __builtin_amdgcn_rcpf(1.0f + __expf(-z1[j]))); }
        *(v4u*)(OA + off) = pg8::pack8(o0, o1);
    }
}

template <int PH_LO, int PH_HI>
__global__ void __launch_bounds__(NWAVES * 64, 2) hybrid_fwd(Args args) {
    extern __shared__ __attribute__((aligned(16))) unsigned char lds_raw[];
    LAS unsigned char* lds = (LAS unsigned char*)lds_raw;
    const int G = gridDim.x;
    volatile LAS unsigned* MISC = (volatile LAS unsigned*)(lds + MISC_OFF);
    if (threadIdx.x < 64) MISC[threadIdx.x] = 0u;
#define PHASE_IDS() int tid = threadIdx.x; asm volatile("" : "+v"(tid)); const int lane = tid & 63, wave = __builtin_amdgcn_readfirstlane(tid >> 6); (void)lane; (void)wave
    __syncthreads();
    unsigned char* ws = args.ws;
    unsigned* ctl = (unsigned*)(ws + WS_CTL);
    XcdBarrier bar; bar.bar = ctl + CW_BAR; bar.x = 0; bar.st = nullptr;
    if (PH_HI - PH_LO > 1) bar = xcd_barrier_post(ctl + CW_BAR, MISC + 8);
#define GRID_BAR() do { xcd_barrier(bar); } while (0)
#define IN(k) (PH_LO <= (k) && (k) < PH_HI)
#define BOTH(k) (IN(k) && IN((k) + 1))
    bf16* XN = (bf16*)(ws + WS_XN);

    if constexpr (IN(0)) { PHASE_IDS(); p0_prologue(args, lds, G, tid, wave, lane); if constexpr (BOTH(0)) GRID_BAR(); }

    if constexpr (IN(1)) { PHASE_IDS();
        pg8::Gemm g{XN, (const bf16*)(ws + WS_WIN), MT, NIN, D}; pg8::StaticOrder S; S.init(MT, NIN, G, (int)blockIdx.x);
        pg8::EpiInProj E{(bf16*)(ws + WS_QKVRAW), (bf16*)(ws + WS_Z), (bf16*)(ws + WS_QSB), (bf16*)(ws + WS_KSB), (bf16*)(ws + WS_VSB), (bf16*)(ws + WS_GATES), (float*)(ws + WS_AB), args.out};
        pg8::gemm_phase<pg8::EpiInProj, pg8::StaticOrder, true, true>(lds, g, S, E);
        if constexpr (BOTH(1)) GRID_BAR();
    }

    if constexpr (IN(2)) { PHASE_IDS(); p2_conv(args, G, tid, wave, lane); if constexpr (BOTH(2)) GRID_BAR(); }

    if constexpr (IN(3)) { PHASE_IDS();
        const int gw = (int)blockIdx.x * NWAVES + wave, NGW = G * NWAVES;
        for (int it = gw; it < 4096; it += NGW) gdn_prep_unit(args, it >> 4, it & 15, lds + wave * PREP_WL, lane);
        if constexpr (BOTH(3)) GRID_BAR();
    }

    if constexpr (IN(4)) { PHASE_IDS();
        if (blockIdx.x < 32) gdn_scan_wg(args, (int)blockIdx.x, lds, tid, wave, lane);
        for (;;) {
            __syncthreads();
            if (tid == 0) MISC[16] = __hip_atomic_fetch_add(ctl + CW_QUEUE, 1u, __ATOMIC_RELAXED, __HIP_MEMORY_SCOPE_AGENT);
            __syncthreads();
            const unsigned qi = MISC[16];
            if (qi >= 2304u) break;
            if (qi < 2048u) attn_unit<false>(args, 127 - (int)(qi >> 4), (int)(qi & 15u), lds, tid, wave, lane);
            else if (qi < 2176u) attn_unit<true>(args, (int)((qi - 2048u) >> 4), (int)(qi & 15u), lds, tid, wave, lane);
            else gdn_sample_unit(args, (int)((qi - 2176u) >> 4), (int)(qi & 15u), lds, tid);
        }
        if constexpr (BOTH(4)) GRID_BAR();
    }

    if constexpr (IN(5)) { PHASE_IDS(); p5_oanorm(args, G, wave, lane); if constexpr (BOTH(5)) GRID_BAR(); }

    if constexpr (IN(6)) { PHASE_IDS();
        pg8::Gemm g{(const bf16*)(ws + WS_OA), (const bf16*)(ws + WS_WGDN), MT, D, 2048}; pg8::StaticOrder S; S.init(MT, D, G, (int)blockIdx.x);
        pg8::EpiGate<0> E{(const bf16*)(ws + WS_GATES), (bf16*)(ws + WS_M)};
        pg8::gemm_phase<pg8::EpiGate<0>, pg8::StaticOrder, true, true>(lds, g, S, E);
        if constexpr (BOTH(6)) GRID_BAR();
    }
    if constexpr (IN(7)) { PHASE_IDS();
        pg8::Gemm g{(const bf16*)(ws + WS_OB), (const bf16*)(ws + WS_WSB), MT, D, 2048}; pg8::StaticOrder S; S.init(MT, D, G, (int)blockIdx.x);
        pg8::EpiGate<1> E{(const bf16*)(ws + WS_GATES), (bf16*)(ws + WS_M)};
        pg8::gemm_phase<pg8::EpiGate<1>, pg8::StaticOrder, true, true>(lds, g, S, E);
        if constexpr (BOTH(7)) GRID_BAR();
    }
    if constexpr (IN(8)) { PHASE_IDS();
        pg8::Gemm g{(const bf16*)(ws + WS_M), (const bf16*)(ws + WS_WOUT), MT, D, D}; pg8::StaticOrder S; S.init(MT, D, G, (int)blockIdx.x);
        pg8::EpiOutRes E{args.in[0], args.in[1], args.out};
        pg8::gemm_phase<pg8::EpiOutRes, pg8::StaticOrder, true, true>(lds, g, S, E);
        if constexpr (BOTH(8)) GRID_BAR();
    }
    if constexpr (IN(9)) { PHASE_IDS();
        const int gw = (int)blockIdx.x * NWAVES + wave, NGW = G * NWAVES;
        for (int m = gw; m < MT; m += NGW) rms_row_to_bf16(m < REALROWS ? args.out + (size_t)m * D : nullptr, args.in[15], XN + (size_t)m * D, lane);
        if constexpr (BOTH(9)) GRID_BAR();
    }
    if constexpr (IN(10)) { PHASE_IDS();
        pg8::Gemm g{XN, (const bf16*)(ws + WS_WUP), MT, DFF, D}; pg8::StaticOrder S; S.init(MT, DFF, G, (int)blockIdx.x);
        pg8::EpiUp E{(bf16*)(ws + WS_U)};
        pg8::gemm_phase<pg8::EpiUp, pg8::StaticOrder, true, true>(lds, g, S, E);
        if constexpr (BOTH(10)) GRID_BAR();
    }
    if constexpr (IN(11)) { PHASE_IDS();
        pg8::Gemm g{(const bf16*)(ws + WS_U), (const bf16*)(ws + WS_WDOWN), MT, D, DFF}; pg8::StaticOrder S; S.init(MT, D, G, (int)blockIdx.x);
        pg8::EpiDownRes E{args.out};
        pg8::gemm_phase<pg8::EpiDownRes, pg8::StaticOrder, true, true>(lds, g, S, E);
        if constexpr (BOTH(11)) GRID_BAR();
    }
    if constexpr (IN(12)) { PHASE_IDS();
        const int gw = (int)blockIdx.x * NWAVES + wave, NGW = G * NWAVES;
        for (int m = gw; m < REALROWS; m += NGW) rms_row_inplace(args.out + (size_t)m * D, args.in[18], lane);
    }
#undef IN
#undef BOTH
#undef GRID_BAR
}

#if DBG_STAGE
__global__ void dbg_finalize(float* out, int stage) {
    const size_t n = pg8::O_END;
    for (size_t i = (size_t)blockIdx.x * blockDim.x + threadIdx.x; i < n; i += (size_t)gridDim.x * blockDim.x) {
        bool keep;
        if (stage == 1) keep = (i >= pg8::O_KP && i < pg8::O_SP) || (i >= pg8::O_CP && i < pg8::O_SS) || (i >= pg8::O_CS);
        else if (stage == 2) keep = (i >= pg8::O_SP && i < pg8::O_CP) || (i >= pg8::O_SS && i < pg8::O_CS);
        else if (stage == 3) keep = (i >= pg8::O_SS && i < pg8::O_CS);
        else keep = (i >= pg8::O_SP && i < pg8::O_CP);
        out[i] = keep ? 3.0f * out[i] : 0.f;
    }
}
#endif


template <int LO, int HI> static bool set_attr_one() { return hipFuncSetAttribute((const void*)hybrid_fwd<LO, HI>, hipFuncAttributeMaxDynamicSharedMemorySize, LDS_BYTES) == hipSuccess; }
template <int LO, int HI> static void launch_one(int grid, hipStream_t stream, const Args& a) { hipLaunchKernelGGL((hybrid_fwd<LO, HI>), dim3(grid), dim3(NWAVES * 64), LDS_BYTES, stream, a); }
#if MK_N_LAUNCHES == 1
static bool set_attrs() { return set_attr_one<0, NPH>(); }
static void launch_all(int grid, hipStream_t stream, const Args& a, int last) { (void)last; launch_one<0, NPH>(grid, stream, a); }
#else
static bool set_attrs() { return set_attr_one<0, 1>() && set_attr_one<1, 2>() && set_attr_one<2, 3>() && set_attr_one<3, 4>() && set_attr_one<4, 5>() && set_attr_one<5, 6>() && set_attr_one<6, 7>() && set_attr_one<7, 8>() && set_attr_one<8, 9>() && set_attr_one<9, 10>() && set_attr_one<10, 11>() && set_attr_one<11, 12>() && set_attr_one<12, 13>(); }
static void launch_all(int grid, hipStream_t stream, const Args& a, int last) {
    if (last > 0) launch_one<0, 1>(grid, stream, a); if (last > 1) launch_one<1, 2>(grid, stream, a); if (last > 2) launch_one<2, 3>(grid, stream, a); if (last > 3) launch_one<3, 4>(grid, stream, a);
    if (last > 4) launch_one<4, 5>(grid, stream, a); if (last > 5) launch_one<5, 6>(grid, stream, a); if (last > 6) launch_one<6, 7>(grid, stream, a); if (last > 7) launch_one<7, 8>(grid, stream, a);
    if (last > 8) launch_one<8, 9>(grid, stream, a); if (last > 9) launch_one<9, 10>(grid, stream, a); if (last > 10) launch_one<10, 11>(grid, stream, a); if (last > 11) launch_one<11, 12>(grid, stream, a);
    if (last > 12) launch_one<12, 13>(grid, stream, a);
}
#endif
extern "C" void kernel_launch(void* const* d_in, const int* in_sizes, int n_in, void* d_out, int out_size, void* d_ws, size_t ws_size, hipStream_t stream) {
    static int grid = 0;
    if (grid == 0) {
        if (n_in != 19 || (size_t)out_size != pg8::O_END || ws_size < WS_END) { fprintf(stderr, "kernel_launch: shape mismatch: n_in %d out %d ws %zu (need >= %zu); nothing launched\n", n_in, out_size, ws_size, (size_t)WS_END); grid = -1; return; }
        int dev = 0, cus = 0, per_cu = 0;
        if (hipGetDevice(&dev) != hipSuccess || hipDeviceGetAttribute(&cus, hipDeviceAttributeMultiprocessorCount, dev) != hipSuccess) { grid = -1; return; }
        if (!set_attrs()) { fprintf(stderr, "kernel_launch: hipFuncSetAttribute failed\n"); grid = -1; return; }
        (void)hipGetLastError();
        grid = cus;
        if (grid < 32) { grid = -1; return; }
    }
    if (grid < 0) return;
    if (hipMemsetAsync((char*)d_ws + WS_CTL, 0, CTL_ZERO_BYTES, stream) != hipSuccess) return;
    Args a{};
    for (int i = 0; i < 19; ++i) a.in[i] = (const float*)d_in[i];
    a.out = (float*)d_out; a.ws = (unsigned char*)d_ws;
#if DBG_STAGE == 1
    const int last = 2;
#elif DBG_STAGE >= 2
    const int last = 5;
#else
    const int last = NPH;
#endif
    launch_all(grid, stream, a, last);
#if DBG_STAGE
    hipLaunchKernelGGL(dbg_finalize, dim3(2048), dim3(256), 0, stream, (float*)d_out, (int)DBG_STAGE);
#endif
}
```

```cpp
#include <hip/hip_runtime.h>
#include <cstdio>
#include <cstdint>
#ifndef MK_N_LAUNCHES
#define MK_N_LAUNCHES 1
#endif
#ifndef DBG_STAGE
#define DBG_STAGE 0
#endif
#undef MK_N_LAUNCHES
#define MK_N_LAUNCHES 1
namespace pg8 {
#define PG8_LAS __attribute__((address_space(3)))
typedef unsigned short bf16_t;
typedef short bf16x8 __attribute__((ext_vector_type(8)));
typedef float f32x4 __attribute__((ext_vector_type(4)));
typedef unsigned u32x4 __attribute__((ext_vector_type(4)));
constexpr int BM = 256, BK = 64, HALF = 128, HTB = HALF * BK * 2  , STAGE_BYTES = 8 * HTB, NXCD = 8, WGM = 8;

__host__ __device__ __forceinline__ int lds_byte(int r, int c) { const int st = (r >> 4) * 2 + (c >> 5), rr = r & 15, cc = c & 31, ob = rr * 64 + cc * 2; return st * 1024 + (ob ^ (((ob >> 9) & 1) << 5)); }
__host__ __device__ __forceinline__ void stage_rc(int b, int& R, int& C) { const int st = b / 1024, sb = b % 1024, swz = sb ^ (((sb >> 9) & 1) << 5); R = (st >> 1) * 16 + swz / 64; C = (st & 1) * 32 + (swz % 64) / 2; }
__host__ __device__ __forceinline__ int perm32(int rho) { const int n = rho >> 4, i = rho & 15; return 8 * (i >> 2) + 4 * n + (i & 3); }

struct Unit { int pm, pn, kb, nt; };
struct Gemm { const bf16_t* A; const bf16_t* Bt; int M, N, K; };

struct StaticOrder {
    int nM, nN, nwg, G, c, ntk;
    __host__ __device__ void init(int M, int N, int G_, int c_, int K_ = 0) { nM = M / BM; nN = N / BM; nwg = nM * nN; G = G_; c = c_; ntk = K_ / BK; }
    __host__ __device__ bool next(int i, Unit& u) const {
        const long L = (long)i * G + c; if (L >= nwg) return false;
        int wgid = (int)L; { const int q = nwg / NXCD, r = nwg % NXCD, xcd = wgid % NXCD, off = wgid / NXCD; wgid = (xcd < r ? xcd * (q + 1) : r * (q + 1) + (xcd - r) * q) + off; }
        const int nig = WGM * nN, gid = wgid / nig, fm = gid * WGM, gsz = (nM - fm) < WGM ? (nM - fm) : WGM;
        u.pm = fm + ((wgid % nig) % gsz); u.pn = (wgid % nig) / gsz; u.kb = 0; u.nt = ntk; return true;
    }
    __device__ __forceinline__ void a_ready(const Unit&) const {}
    __device__ __forceinline__ void done(const Unit&) const {}
};

struct MixOrder : StaticOrder {
    int rounds_p, ksplit, nts, nsub;
    __host__ __device__ void init_mix(int N, int K_, int G_, int c_, int ksplit_) { init(64 * BM, N, G_, c_, K_); rounds_p = nwg / G_; ksplit = ksplit_; nts = ntk / ksplit_; nsub = nN * ksplit_; }
    __host__ __device__ bool next(int i, Unit& u) const {
        if (i < rounds_p) return StaticOrder::next(i, u);
        const int j = (i - rounds_p) * G + c; if (j >= nsub) return false;
        u.pm = 64; u.pn = j / ksplit; const int ks = j % ksplit; u.kb = ks * nts * BK * 2; u.nt = nts; return true;
    }
};
typedef float f32x2c __attribute__((ext_vector_type(2))); typedef __bf16 bf16x2c __attribute__((ext_vector_type(2)));
__device__ __forceinline__ unsigned cvt_pk_bf16(float lo, float hi) { const f32x2c v = {lo, hi}; return __builtin_bit_cast(unsigned, __builtin_convertvector(v, bf16x2c)); }
constexpr int PROWS = 16384, REALROWS = 16512;
constexpr size_t O_YP = 0, O_YS = 67108864, O_KP = 67633152, O_VP = 101187584, O_SP = 134742016, O_CP = 135004160, O_KS = 135016448, O_VS = 135278592, O_SS = 135540736, O_CS = 137637888, O_END = 137736192;
__device__ __forceinline__ float sigmoidf_fast(float x) { return __builtin_amdgcn_rcpf(1.0f + __expf(-x)); }
__device__ __forceinline__ u32x4 pack8(const f32x4 v0, const f32x4 v1) { u32x4 w; w.x = cvt_pk_bf16(v0[0], v0[1]); w.y = cvt_pk_bf16(v0[2], v0[3]); w.z = cvt_pk_bf16(v1[0], v1[1]); w.w = cvt_pk_bf16(v1[2], v1[3]); return w; }
__device__ __forceinline__ void unpack8(const u32x4 w, f32x4& v0, f32x4& v1) {
    v0[0] = __uint_as_float(w.x << 16); v0[1] = __uint_as_float(w.x & 0xffff0000u); v0[2] = __uint_as_float(w.y << 16); v0[3] = __uint_as_float(w.y & 0xffff0000u);
    v1[0] = __uint_as_float(w.z << 16); v1[1] = __uint_as_float(w.z & 0xffff0000u); v1[2] = __uint_as_float(w.w << 16); v1[3] = __uint_as_float(w.w & 0xffff0000u); }

struct EpiInProj {
    static constexpr bool PERM = true, AFTER_DRAIN = false;
    bf16_t *qkvraw, *z, *qsb, *ksb, *vsb, *gates; float* ab; float* out;
    __device__ __forceinline__ void operator()(const f32x4 (&acc)[2][2][4][2], const Unit& u, int wr, int wc, int fr, int fq) const {
        const int pn = u.pn, row0 = u.pm * BM + wr * 64 + fr, cl = wc * 32 + 8 * fq;
        if (pn == 80) {
            if (wc == 0) {
#pragma unroll
                for (int ai = 0; ai < 2; ++ai)
#pragma unroll
                    for (int m = 0; m < 4; ++m) { float* p = ab + (size_t)(row0 + ai * HALF + m * 16) * 32 + cl; *(f32x4*)p = acc[ai][0][m][0]; *(f32x4*)(p + 4) = acc[ai][0][m][1]; }
            }
            return;
        }
        bf16_t* base; int ldc, c0, mode = 0; float* fp = nullptr; float* fs = nullptr;
        if (pn < 16) { base = qkvraw; ldc = 4096; c0 = pn * 256; mode = 3; }
        else if (pn < 24) { base = z; ldc = 2048; c0 = (pn - 16) * 256; }
        else if (pn < 32) { base = qsb; ldc = 2048; c0 = (pn - 24) * 256; }
        else if (pn < 40) { base = ksb; ldc = 2048; c0 = (pn - 32) * 256; mode = 2; fp = out + O_KP; fs = out + O_KS; }
        else if (pn < 48) { base = vsb; ldc = 2048; c0 = (pn - 40) * 256; mode = 2; fp = out + O_VP; fs = out + O_VS; }
        else { base = gates; ldc = 8192; c0 = (pn - 48) * 256; mode = 1; }
#pragma unroll
        for (int ai = 0; ai < 2; ++ai)
#pragma unroll
            for (int m = 0; m < 4; ++m) { const int row = row0 + ai * HALF + m * 16;
#pragma unroll
                for (int bj = 0; bj < 2; ++bj) { f32x4 v0 = acc[ai][bj][m][0], v1 = acc[ai][bj][m][1]; const int col = c0 + bj * HALF + cl;
                    if (mode == 1) {
#pragma unroll
                        for (int j = 0; j < 4; ++j) { v0[j] = sigmoidf_fast(v0[j]); v1[j] = sigmoidf_fast(v1[j]); } }
                    *(u32x4*)(base + (size_t)row * ldc + col) = pack8(v0, v1);
                    if (mode == 2 && row < REALROWS) { float* p = (row < PROWS) ? fp + (size_t)row * 2048 + col : fs + (size_t)(row - PROWS) * 2048 + col; *(f32x4*)p = v0; *(f32x4*)(p + 4) = v1; }
                    if (mode == 3) {
                        if (row >= PROWS - 3 && row < PROWS) { float* p = out + O_CP + (size_t)(row - (PROWS - 3)) * 4096 + col; *(f32x4*)p = v0; *(f32x4*)(p + 4) = v1; }
                        else if (row >= PROWS && row < REALROWS && ((row - PROWS) & 15) >= 13) { const int sr = row - PROWS; float* p = out + O_CS + (size_t)((sr >> 4) * 3 + (sr & 15) - 13) * 4096 + col; *(f32x4*)p = v0; *(f32x4*)(p + 4) = v1; } }
                } }
    }
};
template <int BR> struct EpiGate {
    static constexpr bool PERM = true, AFTER_DRAIN = false;
    const bf16_t* gates; bf16_t* mo;
    __device__ __forceinline__ void operator()(const f32x4 (&acc)[2][2][4][2], const Unit& u, int wr, int wc, int fr, int fq) const {
        const int row0 = u.pm * BM + wr * 64 + fr, col0 = u.pn * BM + wc * 32 + 8 * fq;
#pragma unroll
        for (int ai = 0; ai < 2; ++ai)
#pragma unroll
            for (int m = 0; m < 4; ++m) { const size_t row = (size_t)(row0 + ai * HALF + m * 16);
#pragma unroll
                for (int bj = 0; bj < 2; ++bj) { const int col = col0 + bj * HALF; f32x4 g0, g1; unpack8(*(const u32x4*)(gates + row * 8192 + BR * 4096 + col), g0, g1);
                    f32x4 v0 = acc[ai][bj][m][0] * g0, v1 = acc[ai][bj][m][1] * g1;
                    if (BR == 1) { f32x4 p0, p1; unpack8(*(const u32x4*)(mo + row * 4096 + col), p0, p1); v0 = v0 + p0; v1 = v1 + p1; }
                    *(u32x4*)(mo + row * 4096 + col) = pack8(v0, v1); } }
    }
};
__device__ __forceinline__ void atomic_tile_add(float* h, const f32x4 (&acc)[2][2][4][2], const Unit& u, int wr, int wc, int fr, int fq) {
    const int row0 = u.pm * BM + wr * 64 + fr, col0 = u.pn * BM + wc * 32 + 4 * fq;
#pragma unroll
    for (int m = 0; m < 4; ++m) { float* hr = h + (size_t)(row0 + m * 16) * 4096;
#pragma unroll
        for (int bj = 0; bj < 2; ++bj)
#pragma unroll
            for (int n = 0; n < 2; ++n) { float* p = hr + col0 + bj * HALF + n * 16;
#pragma unroll
                for (int j = 0; j < 4; ++j) unsafeAtomicAdd(p + j, acc[0][bj][m][n][j]); } }
}
struct EpiOutRes {
    static constexpr bool PERM = false, AFTER_DRAIN = false;
    const float* xp; const float* xs; float* h;
    __device__ __forceinline__ void operator()(const f32x4 (&acc)[2][2][4][2], const Unit& u, int wr, int wc, int fr, int fq) const {
        if (u.pm == 64) { atomic_tile_add(h, acc, u, wr, wc, fr, fq); return; }
        const int row0 = u.pm * BM + wr * 64 + fr, col0 = u.pn * BM + wc * 32 + 4 * fq;
#pragma unroll
        for (int ai = 0; ai < 2; ++ai)
#pragma unroll
            for (int m = 0; m < 4; ++m) { const int row = row0 + ai * HALF + m * 16; if (row >= REALROWS) continue;
                const float* xr = (row < PROWS) ? xp + (size_t)row * 4096 : xs + (size_t)(row - PROWS) * 4096; float* hr = h + (size_t)row * 4096;
#pragma unroll
                for (int bj = 0; bj < 2; ++bj)
#pragma unroll
                    for (int n = 0; n < 2; ++n) { const int c = col0 + bj * HALF + n * 16; *(f32x4*)(hr + c) = *(const f32x4*)(xr + c) + acc[ai][bj][m][n]; } }
    }
};
struct EpiUp {
    static constexpr bool PERM = true, AFTER_DRAIN = false;
    bf16_t* U;
    __device__ __forceinline__ void operator()(const f32x4 (&acc)[2][2][4][2], const Unit& u, int wr, int wc, int fr, int fq) const {
        const int row0 = u.pm * BM + wr * 64 + fr, col0 = u.pn * BM + wc * 32 + 8 * fq;
#pragma unroll
        for (int ai = 0; ai < 2; ++ai)
#pragma unroll
            for (int m = 0; m < 4; ++m) { bf16_t* rowp = U + (size_t)(row0 + ai * HALF + m * 16) * 16384 + col0;
#pragma unroll
                for (int bj = 0; bj < 2; ++bj) { f32x4 v0 = acc[ai][bj][m][0], v1 = acc[ai][bj][m][1];
#pragma unroll
                    for (int j = 0; j < 4; ++j) { const float a = fmaxf(v0[j], 0.f), b = fmaxf(v1[j], 0.f); v0[j] = a * a; v1[j] = b * b; }
                    *(u32x4*)(rowp + bj * HALF) = pack8(v0, v1); } }
    }
};
struct EpiDownRes {
    static constexpr bool PERM = false, AFTER_DRAIN = false;
    float* h;
    __device__ __forceinline__ void operator()(const f32x4 (&acc)[2][2][4][2], const Unit& u, int wr, int wc, int fr, int fq) const {
        if (u.pm == 64) { atomic_tile_add(h, acc, u, wr, wc, fr, fq); return; }
        const int row0 = u.pm * BM + wr * 64 + fr, col0 = u.pn * BM + wc * 32 + 4 * fq;
#pragma unroll
        for (int ai = 0; ai < 2; ++ai)
#pragma unroll
            for (int m = 0; m < 4; ++m) { const int row = row0 + ai * HALF + m * 16; if (row >= REALROWS) continue; float* hr = h + (size_t)row * 4096;
#pragma unroll
                for (int bj = 0; bj < 2; ++bj)
#pragma unroll
                    for (int n = 0; n < 2; ++n) { const int c = col0 + bj * HALF + n * 16; *(f32x4*)(hr + c) = *(const f32x4*)(hr + c) + acc[ai][bj][m][n]; } }
    }
};
template <class Epi, class Sched, bool ALIGN_EPI = false, bool SP2 = false>
__device__ __forceinline__ void gemm_phase(PG8_LAS unsigned char* lds, const Gemm g, const Sched& S, const Epi& E) {
    int tid = threadIdx.x; asm volatile("" : "+v"(tid));
    const int wid = __builtin_amdgcn_readfirstlane(tid >> 6), lane = tid & 63, wr = wid >> 2, wc = wid & 3, fr = lane & 15, fq = lane >> 4;
    const int K = g.K;
    unsigned voffA[2], voffB[2];
#pragma unroll
    for (int i = 0; i < 2; ++i) { int R, C; stage_rc(tid * 16 + i * 8192, R, C); const int Rb = Epi::PERM ? ((R & ~31) + perm32(R & 31)) : R;
        voffA[i] = (unsigned)(R * K + C) * 2u; voffB[i] = (unsigned)(Rb * K + C) * 2u; }
    const size_t kstep = (size_t)(BK * 2);
    const size_t hstep = (size_t)HALF * K * 2;
    const size_t tstep = 2 * hstep;
    const unsigned ldsw = (unsigned)wid * 1024u;
    const int aoff = lds_byte(wr * 64 + fr, fq * 8), boff = lds_byte(wc * 32 + fr, fq * 8);
#define PG8_SA(b, h) (((b) * 2 + (h)) * HTB)
#define PG8_SB(b, h) ((4 + (b) * 2 + (h)) * HTB)
#define PG8_STAGE(bufoff, gbase, voff) do { _Pragma("unroll") for (int _i = 0; _i < 2; ++_i) \
        __builtin_amdgcn_global_load_lds((const unsigned*)((const char*)(gbase) + (voff)[_i]), (PG8_LAS unsigned*)(lds + (bufoff) + ldsw + _i * 8192), 16, 0, 0); } while (0)
#define PG8_LDA(dst, b, h) do { _Pragma("unroll") for (int m = 0; m < 4; ++m) _Pragma("unroll") for (int k = 0; k < 2; ++k) dst[m][k] = *(const PG8_LAS bf16x8*)(lds + PG8_SA(b, h) + aoff + m * 2048 + k * 1024); } while (0)
#define PG8_LDB(dst, b, h) do { _Pragma("unroll") for (int n = 0; n < 2; ++n) _Pragma("unroll") for (int k = 0; k < 2; ++k) dst[n][k] = *(const PG8_LAS bf16x8*)(lds + PG8_SB(b, h) + boff + n * 2048 + k * 1024); } while (0)
#define PG8_MMA(ai, bj, At, Bt) do { __builtin_amdgcn_s_setprio(1); _Pragma("unroll") for (int m = 0; m < 4; ++m) _Pragma("unroll") for (int n = 0; n < 2; ++n) _Pragma("unroll") for (int k = 0; k < 2; ++k) \
        acc[ai][bj][m][n] = __builtin_amdgcn_mfma_f32_16x16x32_bf16(Bt[n][k], At[m][k], acc[ai][bj][m][n], 0, 0, 0); __builtin_amdgcn_s_setprio(0); } while (0)
#define PG8_WAIT_V(n) asm volatile("s_waitcnt vmcnt(" #n ")" ::: "memory")
#define PG8_WAIT_L(n) asm volatile("s_waitcnt lgkmcnt(" #n ")" ::: "memory")
#define PG8_BAR __builtin_amdgcn_s_barrier()
#define PG8_SCHED __builtin_amdgcn_sched_barrier(0)
    Unit cur, nxt; int ui = 0;
    if (!S.next(0, cur)) return;
    f32x4 acc[2][2][4][2];
#pragma unroll
    for (int a = 0; a < 2; ++a)
#pragma unroll
        for (int b = 0; b < 2; ++b)
#pragma unroll
            for (int m = 0; m < 4; ++m)
#pragma unroll
                for (int n = 0; n < 2; ++n) acc[a][b][m][n] = (f32x4){0.f, 0.f, 0.f, 0.f};
    bf16x8 At[4][2], B0[2][2], B1[2][2];
    const char* cA = (const char*)g.A + (size_t)cur.pm * tstep + cur.kb; const char* cB = (const char*)g.Bt + (size_t)cur.pn * tstep + cur.kb;
    S.a_ready(cur);
    if constexpr (SP2) {
        PG8_STAGE(PG8_SB(0, 0), cB, voffB); PG8_STAGE(PG8_SB(0, 1), cB + hstep, voffB); PG8_STAGE(PG8_SA(0, 0), cA, voffA); PG8_STAGE(PG8_SA(0, 1), cA + hstep, voffA);
        if (wr == 1) PG8_BAR;
        PG8_WAIT_V(2); PG8_BAR;
        PG8_STAGE(PG8_SB(1, 0), cB + kstep, voffB); PG8_STAGE(PG8_SA(1, 0), cA + kstep, voffA); PG8_STAGE(PG8_SB(1, 1), cB + hstep + kstep, voffB);
        PG8_WAIT_V(6); PG8_BAR;
    } else {
        PG8_STAGE(PG8_SB(0, 0), cB, voffB); PG8_STAGE(PG8_SA(0, 0), cA, voffA); PG8_STAGE(PG8_SB(0, 1), cB + hstep, voffB); PG8_STAGE(PG8_SA(0, 1), cA + hstep, voffA);
        if (wr == 1) PG8_BAR;
        PG8_WAIT_V(4); PG8_BAR;
        PG8_STAGE(PG8_SB(1, 0), cB + kstep, voffB); PG8_STAGE(PG8_SA(1, 0), cA + kstep, voffA); PG8_STAGE(PG8_SB(1, 1), cB + hstep + kstep, voffB);
        PG8_WAIT_V(6); PG8_BAR;
    }
    for (;;) {
        const bool has_next = S.next(ui + 1, nxt);
        const char* nA = has_next ? (const char*)g.A + (size_t)nxt.pm * tstep + nxt.kb : cA; const char* nB = has_next ? (const char*)g.Bt + (size_t)nxt.pn * tstep + nxt.kb : cB;
        const int nt = cur.nt;
        for (int t = 0; t < nt; t += 2) {
            const bool last = (t == nt - 2);
            const char* a1 = cA + (size_t)(t + 1) * kstep;
            const char* a2 = last ? nA : cA + (size_t)(t + 2) * kstep; const char* b2 = last ? nB : cB + (size_t)(t + 2) * kstep;
            const char* a3 = a2 + kstep; const char* b3 = b2 + kstep;
            if (last && has_next) S.a_ready(nxt);
            if constexpr (SP2) {
            PG8_LDB(B0, 0, 0); PG8_LDB(B1, 0, 1); PG8_SCHED; PG8_LDA(At, 0, 0); PG8_STAGE(PG8_SA(1, 1), a1 + hstep, voffA);
            PG8_WAIT_V(8); PG8_WAIT_L(0); PG8_BAR; PG8_MMA(0, 0, At, B0); PG8_MMA(0, 1, At, B1); PG8_BAR; PG8_SCHED;
            PG8_LDA(At, 0, 1); PG8_STAGE(PG8_SB(0, 0), b2, voffB); PG8_STAGE(PG8_SB(0, 1), b2 + hstep, voffB); PG8_STAGE(PG8_SA(0, 0), a2, voffA);
            PG8_WAIT_V(8); PG8_WAIT_L(0); PG8_BAR; PG8_MMA(1, 0, At, B0); PG8_MMA(1, 1, At, B1); PG8_BAR; PG8_SCHED;
            PG8_LDB(B0, 1, 0); PG8_LDB(B1, 1, 1); PG8_SCHED; PG8_LDA(At, 1, 0); PG8_STAGE(PG8_SA(0, 1), a2 + hstep, voffA);
            PG8_WAIT_V(8); PG8_WAIT_L(0); PG8_BAR; PG8_MMA(0, 0, At, B0); PG8_MMA(0, 1, At, B1); PG8_BAR; PG8_SCHED;
            PG8_LDA(At, 1, 1); PG8_STAGE(PG8_SB(1, 0), b3, voffB); PG8_STAGE(PG8_SB(1, 1), b3 + hstep, voffB); PG8_STAGE(PG8_SA(1, 0), a3, voffA);
            PG8_WAIT_V(8); PG8_WAIT_L(0); PG8_BAR; PG8_MMA(1, 0, At, B0); PG8_MMA(1, 1, At, B1); PG8_BAR; PG8_SCHED;
            } else {
            PG8_LDB(B0, 0, 0); PG8_SCHED; PG8_LDA(At, 0, 0); PG8_STAGE(PG8_SA(1, 1), a1 + hstep, voffA);
            PG8_WAIT_L(8); PG8_BAR; PG8_WAIT_L(0); PG8_MMA(0, 0, At, B0); PG8_BAR; PG8_SCHED;
            PG8_LDB(B1, 0, 1); PG8_STAGE(PG8_SB(0, 0), b2, voffB);
            PG8_BAR; PG8_WAIT_L(0); PG8_MMA(0, 1, At, B1); PG8_BAR;
            PG8_LDA(At, 0, 1); PG8_STAGE(PG8_SA(0, 0), a2, voffA);
            PG8_BAR; PG8_WAIT_L(0); PG8_MMA(1, 0, At, B0); PG8_BAR; PG8_SCHED;
            PG8_STAGE(PG8_SB(0, 1), b2 + hstep, voffB);
            PG8_WAIT_V(6); PG8_BAR; PG8_MMA(1, 1, At, B1); PG8_BAR;
            PG8_LDB(B0, 1, 0); PG8_SCHED; PG8_LDA(At, 1, 0); PG8_STAGE(PG8_SA(0, 1), a2 + hstep, voffA);
            PG8_WAIT_L(8); PG8_BAR; PG8_WAIT_L(0); PG8_MMA(0, 0, At, B0); PG8_BAR; PG8_SCHED;
            PG8_LDB(B1, 1, 1); PG8_STAGE(PG8_SB(1, 0), b3, voffB);
            PG8_BAR; PG8_WAIT_L(0); PG8_MMA(0, 1, At, B1); PG8_BAR;
            PG8_LDA(At, 1, 1); PG8_STAGE(PG8_SA(1, 0), a3, voffA);
            PG8_BAR; PG8_WAIT_L(0); PG8_MMA(1, 0, At, B0); PG8_BAR; PG8_SCHED;
            PG8_STAGE(PG8_SB(1, 1), b3 + hstep, voffB);
            PG8_WAIT_V(6); PG8_BAR; PG8_MMA(1, 1, At, B1); PG8_BAR;
            }
        }
        if constexpr (ALIGN_EPI) { if (wr == 0) PG8_BAR; }
        if constexpr (!Epi::AFTER_DRAIN) { E(acc, cur, wr, wc, fr, fq); S.done(cur); }
        if (!has_next) break;
#pragma unroll
        for (int a = 0; a < 2; ++a)
#pragma unroll
            for (int b = 0; b < 2; ++b)
#pragma unroll
                for (int m = 0; m < 4; ++m)
#pragma unroll
                    for (int n = 0; n < 2; ++n) acc[a][b][m][n] = (f32x4){0.f, 0.f, 0.f, 0.f};
        cur = nxt; cA = nA; cB = nB; ++ui;
        if constexpr (ALIGN_EPI) { if (wr == 1) PG8_BAR; }
    }
    PG8_WAIT_V(0);
    if constexpr (!ALIGN_EPI) { if (wr == 0) PG8_BAR; }
    PG8_BAR;
    if constexpr (Epi::AFTER_DRAIN) { E.fused(acc, cur, wr, wc, fr, fq, lds, wid, lane); S.done(cur); }
#undef PG8_SA
#undef PG8_SB
#undef PG8_STAGE
#undef PG8_LDA
#undef PG8_LDB
#undef PG8_MMA
#undef PG8_WAIT_V
#undef PG8_WAIT_L
#undef PG8_BAR
#undef PG8_SCHED
}
}
constexpr int NWAVES = 8;
constexpr int D = 4096, SEQ = 16384, MT = 16640, DFF = 16384, NIN = 20736;
constexpr int PROWS = pg8::PROWS, REALROWS = pg8::REALROWS;
constexpr int NPH = 13;
constexpr size_t MiB = 1u << 20;
constexpr size_t WS_CTL = 0, CTL_ZERO_BYTES = 1 * MiB;
constexpr size_t WS_WUP = 1 * MiB, WS_WDOWN = 129 * MiB, WS_WOUT = 257 * MiB, WS_WGDN = 289 * MiB, WS_WSB = 305 * MiB;
constexpr size_t WS_XN = 321 * MiB;
constexpr size_t WS_GATES = 451 * MiB;
constexpr size_t WS_WIN = 711 * MiB;
constexpr size_t WS_QKVRAW = 873 * MiB;
constexpr size_t WS_Z = 1003 * MiB, WS_QSB = 1068 * MiB, WS_KSB = 1133 * MiB, WS_VSB = 1198 * MiB;
constexpr size_t WS_AB = 1263 * MiB, WS_GB = 1266 * MiB;
constexpr size_t WS_OA = 1269 * MiB, WS_OB = 1334 * MiB;
constexpr size_t WS_EV = 1399 * MiB;
constexpr size_t WS_AQK = 1401 * MiB, WS_KT = 1433 * MiB;
constexpr size_t WS_SMP = 1465 * MiB;
constexpr size_t WS_END = 1467 * MiB;
constexpr size_t WS_GQ = WS_WIN, WS_GK = WS_WIN + 33 * MiB, WS_GVT = WS_WIN + 66 * MiB;
constexpr size_t WS_U0F = WS_XN, WS_W = WS_XN + 64 * MiB;
constexpr size_t WS_M = WS_QKVRAW, WS_U = WS_WIN;
static_assert(WS_GVT + 64 * MiB <= WS_QKVRAW && WS_W + 64 * MiB <= WS_GATES && WS_U + (size_t)MT * DFF * 2 <= WS_AB, "d_ws aliases");
constexpr int CW_BAR = 4096;
constexpr int CW_QUEUE = 16384;
constexpr int RING_BYTES = 131072;
constexpr int LDS_BYTES = 147456;
constexpr int MISC_OFF = LDS_BYTES - 256;

#define GAS __attribute__((address_space(1)))
#define LAS __attribute__((address_space(3)))
typedef unsigned short bf16;
typedef unsigned v4u __attribute__((ext_vector_type(4)));
typedef unsigned v2u __attribute__((ext_vector_type(2)));
typedef float f32x4 __attribute__((ext_vector_type(4)));
typedef float f32x2 __attribute__((ext_vector_type(2)));
typedef short bf16x8 __attribute__((ext_vector_type(8)));
typedef short bf16x4 __attribute__((ext_vector_type(4)));
#define LDS_WAIT() asm volatile("s_waitcnt lgkmcnt(0)" ::: "memory")
#define VM_WAIT() asm volatile("s_waitcnt vmcnt(0)" ::: "memory")
__device__ __forceinline__ unsigned pk2(float lo, float hi) { return pg8::cvt_pk_bf16(lo, hi); }
__device__ __forceinline__ float bflo(unsigned w) { return __uint_as_float(w << 16); }
__device__ __forceinline__ float bfhi(unsigned w) { return __uint_as_float(w & 0xffff0000u); }
__device__ __forceinline__ float wave_sum(float v) {
#pragma unroll
    for (int o = 1; o < 64; o <<= 1) v += __shfl_xor(v, o);
    return v;
}
__device__ __forceinline__ float wave_max(float v) {
#pragma unroll
    for (int o = 1; o < 64; o <<= 1) v = fmaxf(v, __shfl_xor(v, o));
    return v;
}
__device__ __forceinline__ float softplusf(float x) { return fmaxf(x, 0.f) + __logf(1.0f + __expf(-fabsf(x))); }
__device__ __forceinline__ f32x4 mfma16(bf16x8 a, bf16x8 b, f32x4 c) { return __builtin_amdgcn_mfma_f32_16x16x32_bf16(a, b, c, 0, 0, 0); }
__device__ __forceinline__ bf16x8 mk8(v2u lo, v2u hi) { v4u w; w.x = lo.x; w.y = lo.y; w.z = hi.x; w.w = hi.y; return __builtin_bit_cast(bf16x8, w); }

#define XB_TMO      128
#define XB_XCNT(j)  (256  + 64 * (j))
#define XB_XSUB(j)  (1280 + 64 * (j))
#define XB_XGEN(j)  (2304 + 64 * (j))
#define XB_TOP      3328
#define XB_TOPGEN   3392
#define XCD_BAR_WORDS 3456
#define XB_SPIN_CAP (1u << 18)
#define LAS __attribute__((address_space(3)))

__device__ __forceinline__ unsigned xb_ld(unsigned* p)              { return __hip_atomic_load(p, __ATOMIC_RELAXED, __HIP_MEMORY_SCOPE_AGENT); }
__device__ __forceinline__ unsigned xb_add(unsigned* p, unsigned v) { return __hip_atomic_fetch_add(p, v, __ATOMIC_RELAXED, __HIP_MEMORY_SCOPE_AGENT); }
__device__ __forceinline__ unsigned xb_xcc_id() { return (unsigned)__builtin_amdgcn_s_getreg((3 << 11) | 20) & 0xFu; }
#define XB_SPIN(cond, bar) do { unsigned _sp = 0; while (cond) { __builtin_amdgcn_s_sleep(1); \
    if ((++_sp & 255u) == 0u) { if (xb_ld(&(bar)[XB_TMO])) break; if (_sp > XB_SPIN_CAP) { atomicAdd(&(bar)[XB_TMO], 1u); break; } } } } while (0)

struct XcdBarrier {
    unsigned* bar; unsigned x;
    volatile LAS unsigned* st;
};

__device__ __forceinline__ XcdBarrier xcd_barrier_post(unsigned* bar, volatile LAS unsigned* st) {
    XcdBarrier b; b.bar = bar; b.x = xb_xcc_id(); b.st = st;
    if (threadIdx.x == 0) (void)xb_add(&bar[XB_XCNT(b.x)], 1u);
    return b;
}
__device__ __forceinline__ void xcd_barrier_complete(unsigned* bar, unsigned x, unsigned& nloc, unsigned& nx) {
    const unsigned G = gridDim.x * gridDim.y * gridDim.z;
    unsigned sum, cnt, mine, sp = 0u;
    for (;;) {
        sum = 0u; cnt = 0u; mine = 0u;
#pragma unroll
        for (unsigned j = 0; j < 16; ++j) { const unsigned c = xb_ld(&bar[XB_XCNT(j)]); sum += c; cnt += (c > 0u) ? 1u : 0u; mine = (j == x) ? c : mine; }
        if (sum == G) break;
        __builtin_amdgcn_s_sleep(1);
        if ((++sp & 255u) == 0u) { if (xb_ld(&bar[XB_TMO])) break; if (sp > XB_SPIN_CAP) { atomicAdd(&bar[XB_TMO], 1u); break; } }
    }
    nloc = mine > 0u ? mine : 1u; nx = cnt > 0u ? cnt : 1u;
}

__device__ __forceinline__ void xcd_barrier(const XcdBarrier& b) {
    asm volatile("s_waitcnt vmcnt(0)" ::: "memory");
    __syncthreads();
    if (threadIdx.x == 0) {
        unsigned* bar = b.bar;
        __builtin_amdgcn_s_waitcnt(0);
        unsigned nloc = b.st[0], nx = b.st[1];
        if (nloc == 0u) { xcd_barrier_complete(bar, b.x, nloc, nx); b.st[0] = nloc; b.st[1] = nx; }
        const unsigned old = xb_add(&bar[XB_XSUB(b.x)], 1u);
        const unsigned gen = old / nloc;
        if (old + 1u == (gen + 1u) * nloc) {
            __builtin_amdgcn_fence(__ATOMIC_RELEASE, "agent");
            asm volatile("s_waitcnt vmcnt(0)" ::: "memory");
            const unsigned og = xb_add(&bar[XB_TOP], 1u);
            const unsigned tg = og / nx;
            if (og + 1u == (tg + 1u) * nx) xb_add(&bar[XB_TOPGEN], 1u);
            else XB_SPIN(xb_ld(&bar[XB_TOPGEN]) == tg, bar);
            __builtin_amdgcn_fence(__ATOMIC_ACQUIRE, "agent");
            xb_add(&bar[XB_XGEN(b.x)], 1u);
            asm volatile("s_waitcnt vmcnt(0)" ::: "memory");
        } else {
            XB_SPIN(xb_ld(&bar[XB_XGEN(b.x)]) == gen, bar);
            __builtin_amdgcn_fence(__ATOMIC_ACQUIRE, "agent");
            asm volatile("s_waitcnt vmcnt(0)" ::: "memory");
        }
    }
    __syncthreads();
}


struct Args { const float* in[19]; float* out; unsigned char* ws; int ph_lo, ph_hi; };

__device__ __forceinline__ void p0_transpose_item(const float* W, int ldw, bf16* WT, int ldt, int dst_row, int src_col, int k0, LAS float* scr, int lane) {
#pragma unroll 8
    for (int i = 0; i < 32; ++i) { const int kk = 2 * i + (lane >> 5); scr[kk * 33 + (lane & 31)] = W[(size_t)(k0 + kk) * ldw + src_col + (lane & 31)]; }
    LDS_WAIT(); asm volatile("" ::: "memory");
    const int c = lane & 7;
#pragma unroll
    for (int j = 0; j < 4; ++j) { const int n = (lane >> 3) + 8 * j; const LAS float* s = scr + (8 * c) * 33 + n;
        v4u o; o.x = pk2(s[0 * 33], s[1 * 33]); o.y = pk2(s[2 * 33], s[3 * 33]); o.z = pk2(s[4 * 33], s[5 * 33]); o.w = pk2(s[6 * 33], s[7 * 33]);
        *(v4u*)(WT + (size_t)(dst_row + n) * ldt + k0 + 8 * c) = o; }
    LDS_WAIT(); asm volatile("" ::: "memory");
}
__device__ __forceinline__ void rms_row_to_bf16(const float* xrow, const float* w, bf16* orow, int lane) {
    unsigned long long* o8 = (unsigned long long*)orow + lane;
    if (xrow == nullptr) {
#pragma unroll
        for (int j = 0; j < 16; ++j) o8[64 * j] = 0ull;
        return; }
    const f32x4* xr = (const f32x4*)xrow + lane; const f32x4* wr = (const f32x4*)w + lane;
    f32x4 v[16]; float s = 0.f;
#pragma unroll
    for (int j = 0; j < 16; ++j) { v[j] = xr[64 * j]; s += (v[j].x * v[j].x + v[j].y * v[j].y) + (v[j].z * v[j].z + v[j].w * v[j].w); }
    const float r = 1.0f / sqrtf(wave_sum(s) * (1.0f / 4096.0f) + 1e-6f);
#pragma unroll
    for (int j = 0; j < 16; ++j) { const f32x4 ww = wr[64 * j]; const f32x4 o = v[j] * r * ww;
        o8[64 * j] = (unsigned long long)pk2(o.x, o.y) | ((unsigned long long)pk2(o.z, o.w) << 32); }
}
__device__ __forceinline__ void rms_row_inplace(float* xrow, const float* w, int lane) {
    f32x4* xr = (f32x4*)xrow + lane; const f32x4* wr = (const f32x4*)w + lane;
    f32x4 v[16]; float s = 0.f;
#pragma unroll
    for (int j = 0; j < 16; ++j) { v[j] = xr[64 * j]; s += (v[j].x * v[j].x + v[j].y * v[j].y) + (v[j].z * v[j].z + v[j].w * v[j].w); }
    const float r = 1.0f / sqrtf(wave_sum(s) * (1.0f / 4096.0f) + 1e-6f);
#pragma unroll
    for (int j = 0; j < 16; ++j) xr[64 * j] = v[j] * r * wr[64 * j];
}
__device__ __forceinline__ void p0_prologue(const Args& a, LAS unsigned char* lds, int G, int tid, int wave, int lane) {
    unsigned char* ws = a.ws;
    LAS float* scr = (LAS float*)(lds + wave * 16384);
    const int gw = (int)blockIdx.x * NWAVES + wave, NGW = G * NWAVES;
    constexpr int I_IN = 641 * 64, I_G = 128 * 32, I_O = 128 * 64, I_UP = 512 * 64, I_DN = 128 * 256, NITEMS = I_IN + 2 * I_G + I_O + I_UP + I_DN;
    for (int it = gw; it < NITEMS; it += NGW) {
        int r = it;
        if (r < I_IN) { const int kb = r / 641, nb = r % 641; const int sc = nb < 192 ? 32 * nb : (nb < 640 ? 32 * nb + 32 : 6144);
            p0_transpose_item(a.in[7], 20512, (bf16*)(ws + WS_WIN), 4096, 32 * nb, sc, 64 * kb, scr, lane); continue; } r -= I_IN;
        if (r < I_G) { p0_transpose_item(a.in[12], 4096, (bf16*)(ws + WS_WGDN), 2048, 32 * (r % 128), 32 * (r % 128), 64 * (r / 128), scr, lane); continue; } r -= I_G;
        if (r < I_G) { p0_transpose_item(a.in[13], 4096, (bf16*)(ws + WS_WSB), 2048, 32 * (r % 128), 32 * (r % 128), 64 * (r / 128), scr, lane); continue; } r -= I_G;
        if (r < I_O) { p0_transpose_item(a.in[14], 4096, (bf16*)(ws + WS_WOUT), 4096, 32 * (r % 128), 32 * (r % 128), 64 * (r / 128), scr, lane); continue; } r -= I_O;
        if (r < I_UP) { p0_transpose_item(a.in[16], 16384, (bf16*)(ws + WS_WUP), 4096, 32 * (r % 512), 32 * (r % 512), 64 * (r / 512), scr, lane); continue; } r -= I_UP;
        p0_transpose_item(a.in[17], 4096, (bf16*)(ws + WS_WDOWN), 16384, 32 * (r % 128), 32 * (r % 128), 64 * (r / 128), scr, lane);
    }
    { v4u* zp = (v4u*)(ws + WS_WIN + (size_t)20512 * 4096 * 2); const int nz = 224 * 4096 * 2 / 16; const v4u z4 = {0u, 0u, 0u, 0u};
      for (int i = (int)blockIdx.x * (NWAVES * 64) + tid; i < nz; i += G * NWAVES * 64) zp[i] = z4; }
    { const f32x4* xs4 = (const f32x4*)a.in[1]; f32x4* hs4 = (f32x4*)(a.out + pg8::O_YS);
      for (int i = (int)blockIdx.x * (NWAVES * 64) + tid; i < 128 * 4096 / 4; i += G * NWAVES * 64) hs4[i] = xs4[i]; }
    bf16* XN = (bf16*)(ws + WS_XN);
    for (int m = gw; m < MT; m += NGW) {
        const float* xr = m < PROWS ? a.in[0] + (size_t)m * D : (m < REALROWS ? a.in[1] + (size_t)(m - PROWS) * D : nullptr);
        rms_row_to_bf16(xr, a.in[6], XN + (size_t)m * D, lane); }
}

template <int KIND, bool SAMPLE>
__device__ __forceinline__ void conv_unit(const Args& a, int c, int j, int lane) {
    constexpr int NT = SAMPLE ? 16 : 64;
    unsigned char* ws = a.ws;
    const int ch = (KIND == 0 ? 0 : (KIND == 1 ? 1024 : 2048)) + 128 * j + 2 * lane;
    const int row0 = SAMPLE ? PROWS + 16 * c : 64 * c;
    const bf16* raw = (const bf16*)(ws + WS_QKVRAW);
    const float* cw = a.in[8] + ch;
    const f32x2 w0 = *(const f32x2*)(cw), w1 = *(const f32x2*)(cw + 4096), w2 = *(const f32x2*)(cw + 8192), w3 = *(const f32x2*)(cw + 12288);
    f32x2 xm3 = {0.f, 0.f}, xm2 = {0.f, 0.f}, xm1 = {0.f, 0.f};
    if (SAMPLE) { const float* past = a.in[5] + (size_t)c * 3 * 4096 + ch; xm3 = *(const f32x2*)(past); xm2 = *(const f32x2*)(past + 4096); xm1 = *(const f32x2*)(past + 8192); }
    else if (c > 0) { const unsigned p3 = *(const unsigned*)(raw + (size_t)(row0 - 3) * 4096 + ch), p2 = *(const unsigned*)(raw + (size_t)(row0 - 2) * 4096 + ch), p1 = *(const unsigned*)(raw + (size_t)(row0 - 1) * 4096 + ch);
        xm3 = (f32x2){bflo(p3), bfhi(p3)}; xm2 = (f32x2){bflo(p2), bfhi(p2)}; xm1 = (f32x2){bflo(p1), bfhi(p1)}; }
    unsigned tp0[NT / 2], tp1[NT / 2];
#pragma unroll
    for (int t = 0; t < NT; ++t) {
        const unsigned xw = *(const unsigned*)(raw + (size_t)(row0 + t) * 4096 + ch);
        const f32x2 xt = {bflo(xw), bfhi(xw)};
        f32x2 y = w0 * xm3 + w1 * xm2 + w2 * xm1 + w3 * xt;
        xm3 = xm2; xm2 = xm1; xm1 = xt;
        y.x = y.x * __builtin_amdgcn_rcpf(1.0f + __expf(-y.x)); y.y = y.y * __builtin_amdgcn_rcpf(1.0f + __expf(-y.y));
        if (KIND < 2) { const float ss = wave_sum(y.x * y.x + y.y * y.y); const float sc = (1.0f / sqrtf(ss + 1e-6f)) * (KIND == 0 ? 0.08838834764831845f : 1.0f); y = y * sc; }
        if (SAMPLE) {
            float* dst = (float*)(ws + WS_SMP) + (KIND == 0 ? 0 : (KIND == 1 ? 128 * 1024 : 256 * 1024));
            const int ld = KIND == 2 ? 2048 : 1024;
            *(f32x2*)(dst + (size_t)(16 * c + t) * ld + 128 * j + 2 * lane) = y;
        } else {
            const unsigned pk = pk2(y.x, y.y);
            if (KIND == 0) *(unsigned*)((bf16*)(ws + WS_GQ) + (size_t)(row0 + t) * 1024 + 128 * j + 2 * lane) = pk;
            if (KIND == 1) *(unsigned*)((bf16*)(ws + WS_GK) + (size_t)(row0 + t) * 1024 + 128 * j + 2 * lane) = pk;
            if (KIND >= 1) { if ((t & 1) == 0) { tp0[t / 2] = pk & 0xffffu; tp1[t / 2] = pk >> 16; } else { tp0[t / 2] |= pk << 16; tp1[t / 2] |= pk & 0xffff0000u; } }
        }
    }
    if (!SAMPLE && KIND >= 1) {
        bf16* tb = (KIND == 1) ? (bf16*)(ws + WS_KT) + ((size_t)(c * 8 + j) * 128 + 2 * lane) * 64 : (bf16*)(ws + WS_GVT) + ((size_t)(c * 16 + j) * 128 + 2 * lane) * 64;
#pragma unroll
        for (int q = 0; q < NT / 8; ++q) {
            *(v4u*)(tb + 8 * q) = (v4u){tp0[4 * q], tp0[4 * q + 1], tp0[4 * q + 2], tp0[4 * q + 3]};
            *(v4u*)(tb + 64 + 8 * q) = (v4u){tp1[4 * q], tp1[4 * q + 1], tp1[4 * q + 2], tp1[4 * q + 3]}; }
    }
}
__device__ __forceinline__ void p2_conv(const Args& a, int G, int tid, int wave, int lane) {
    const int gw = (int)blockIdx.x * NWAVES + wave, NGW = G * NWAVES;
    for (int it = gw; it < 8192 + 256; it += NGW) {
        if (it < 8192) { const int c = it >> 5, j = it & 31;
            if (j < 8) conv_unit<0, false>(a, c, j, lane); else if (j < 16) conv_unit<1, false>(a, c, j - 8, lane); else conv_unit<2, false>(a, c, j - 16, lane);
        } else { const int c = (it - 8192) >> 5, j = it & 31;
            if (j < 8) conv_unit<0, true>(a, c, j, lane); else if (j < 16) conv_unit<1, true>(a, c, j - 8, lane); else conv_unit<2, true>(a, c, j - 16, lane); }
    }
    const float* ab = (const float*)(a.ws + WS_AB); float* gb = (float*)(a.ws + WS_GB);
    for (int i = (int)blockIdx.x * (NWAVES * 64) + tid; i < REALROWS * 16; i += G * NWAVES * 64) { const int m = i >> 4, h = i & 15;
        const float av = ab[(size_t)m * 32 + h], bv = ab[(size_t)m * 32 + 16 + h];
        gb[(size_t)m * 32 + h] = -__expf(a.in[9][h]) * softplusf(av + a.in[10][h]);
        gb[(size_t)m * 32 + 16 + h] = 1.0f / (1.0f + __expf(-bv)); }
}

constexpr int PREP_MP = 68, PREP_WL = 64 * PREP_MP * 4 + 768;
__device__ __forceinline__ void gdn_prep_unit(const Args& a, int c, int h, LAS unsigned char* wl, int lane) {
    unsigned char* ws = a.ws;
    const int hq = h >> 1, tok0 = 64 * c, unit = c * 16 + h, i16 = lane & 15, g = lane >> 4;
    LAS float* Mx = (LAS float*)wl;
    LAS float* s_gc = (LAS float*)(wl + 64 * PREP_MP * 4); LAS float* s_bt = s_gc + 64; LAS float* s_bg = s_gc + 128;
    const float* gb = (const float*)(ws + WS_GB);
    const float gt = gb[(size_t)(tok0 + lane) * 32 + h], bt = gb[(size_t)(tok0 + lane) * 32 + 16 + h];
    float gc = gt;
#pragma unroll
    for (int o = 1; o < 64; o <<= 1) { const float t = __shfl_up(gc, o); if (lane >= o) gc += t; }
    const float gl = __shfl(gc, 63);
    const float egc = __expf(gc);
    s_gc[lane] = gc; s_bt[lane] = bt; s_bg[lane] = bt * egc;
    { float* ev = (float*)(ws + WS_EV) + (size_t)unit * 128; ev[lane] = egc; ev[64 + lane] = __expf(gl - gc); }
    LDS_WAIT(); asm volatile("" ::: "memory");
    const bf16* GK = (const bf16*)(ws + WS_GK) + (size_t)tok0 * 1024 + hq * 128 + 8 * g; const bf16* GQ = (const bf16*)(ws + WS_GQ) + (size_t)tok0 * 1024 + hq * 128 + 8 * g;
#pragma unroll 1
    for (int I = 0; I < 4; ++I) {
        bf16x8 kI[4];
#pragma unroll
        for (int s = 0; s < 4; ++s) kI[s] = *(const bf16x8*)(GK + (size_t)(16 * I + i16) * 1024 + 32 * s);
        const f32x4 gci = *(const LAS f32x4*)(s_gc + 16 * I + 4 * g), bti = *(const LAS f32x4*)(s_bt + 16 * I + 4 * g);
#pragma unroll 1
        for (int J = 0; J <= I; ++J) {
            f32x4 acc = {0.f, 0.f, 0.f, 0.f};
#pragma unroll
            for (int s = 0; s < 4; ++s) acc = mfma16(kI[s], *(const bf16x8*)(GK + (size_t)(16 * J + i16) * 1024 + 32 * s), acc);
            const int jj = 16 * J + i16; const float gcj = s_gc[jj];
            f32x4 l4;
#pragma unroll
            for (int r = 0; r < 4; ++r) { const int ii = 16 * I + 4 * g + r; l4[r] = (ii > jj) ? bti[r] * acc[r] * __expf(gci[r] - gcj) : 0.f; }
            *(LAS f32x4*)(Mx + jj * PREP_MP + 16 * I + 4 * g) = l4;
        }
    }
    bf16* AQK = (bf16*)(ws + WS_AQK) + (size_t)unit * 4096;
#pragma unroll 1
    for (int I = 0; I < 4; ++I) {
        bf16x8 qf[4];
#pragma unroll
        for (int s = 0; s < 4; ++s) qf[s] = *(const bf16x8*)(GQ + (size_t)(16 * I + i16) * 1024 + 32 * s);
        const int ii = 16 * I + i16; const float gci = s_gc[ii];
#pragma unroll 1
        for (int J = 0; J < 4; ++J) {
            v2u o = {0u, 0u};
            if (J <= I) {
                f32x4 acc = {0.f, 0.f, 0.f, 0.f};
#pragma unroll
                for (int s = 0; s < 4; ++s) acc = mfma16(*(const bf16x8*)(GK + (size_t)(16 * J + i16) * 1024 + 32 * s), qf[s], acc);
                const f32x4 gcj = *(const LAS f32x4*)(s_gc + 16 * J + 4 * g);
                f32x4 v;
#pragma unroll
                for (int r = 0; r < 4; ++r) { const int jj = 16 * J + 4 * g + r; v[r] = (ii >= jj) ? acc[r] * __expf(gci - gcj[r]) : 0.f; }
                o.x = pk2(v[0], v[1]); o.y = pk2(v[2], v[3]);
            }
            *(v2u*)(AQK + (size_t)ii * 64 + 16 * J + 4 * g) = o;
        }
    }
    LDS_WAIT(); asm volatile("" ::: "memory");
#pragma unroll 1
    for (int c2 = 63; c2 >= 0; --c2) {
        float s0 = (lane == c2) ? 1.f : 0.f, s1 = 0.f, s2 = 0.f, s3 = 0.f;
        const LAS float* lrow = Mx + c2 * PREP_MP;
        const LAS float* trow = Mx + lane * PREP_MP;
#pragma unroll 1
        for (int jb = (c2 + 1) >> 4; jb < 4; ++jb) {
            f32x4 l4[4], t4[4];
#pragma unroll
            for (int q = 0; q < 4; ++q) { l4[q] = *(const LAS f32x4*)(lrow + 16 * jb + 4 * q); t4[q] = *(const LAS f32x4*)(trow + 16 * jb + 4 * q); }
#pragma unroll
            for (int q = 0; q < 4; ++q)
#pragma unroll
                for (int e = 0; e < 4; ++e) { const int j = 16 * jb + 4 * q + e; const float p = (j > c2 && j <= lane) ? t4[q][e] * l4[q][e] : 0.f;
                    if (e == 0) s0 -= p; else if (e == 1) s1 -= p; else if (e == 2) s2 -= p; else s3 -= p; }
        }
        if (c2 <= lane) Mx[lane * PREP_MP + c2] = (s0 + s1) + (s2 + s3);
        LDS_WAIT(); asm volatile("" ::: "memory");
    }
    bf16x8 tf[4][2];
#pragma unroll
    for (int I = 0; I < 4; ++I)
#pragma unroll
        for (int s = 0; s < 2; ++s) if (s == 0 || I >= 2) { const int ii = 16 * I + i16, j0 = 32 * s + 8 * g;
            const f32x4 a0 = *(const LAS f32x4*)(Mx + ii * PREP_MP + j0), a1 = *(const LAS f32x4*)(Mx + ii * PREP_MP + j0 + 4);
            float v[8];
#pragma unroll
            for (int e = 0; e < 4; ++e) { v[e] = (j0 + e <= ii) ? a0[e] : 0.f; v[4 + e] = (j0 + 4 + e <= ii) ? a1[e] : 0.f; }
            v4u w; w.x = pk2(v[0], v[1]); w.y = pk2(v[2], v[3]); w.z = pk2(v[4], v[5]); w.w = pk2(v[6], v[7]);
            tf[I][s] = __builtin_bit_cast(bf16x8, w); }
    const bf16* GVT = (const bf16*)(ws + WS_GVT) + (size_t)unit * 128 * 64;
    v2u* U0F = (v2u*)(ws + WS_U0F) + (size_t)unit * 8 * 4 * 64;
    v4u pf[2];
#pragma unroll
    for (int s = 0; s < 2; ++s) pf[s] = *(const v4u*)(GVT + (size_t)(i16) * 64 + 32 * s + 8 * g);
#pragma unroll 1
    for (int N = 0; N < 8; ++N) {
        bf16x8 vb[2]; v4u cur[2] = {pf[0], pf[1]};
        if (N < 7) {
#pragma unroll
            for (int s = 0; s < 2; ++s) pf[s] = *(const v4u*)(GVT + (size_t)(16 * (N + 1) + i16) * 64 + 32 * s + 8 * g); }
#pragma unroll
        for (int s = 0; s < 2; ++s) { const v4u w = cur[s];
            const f32x4 b0 = *(const LAS f32x4*)(s_bt + 32 * s + 8 * g), b1 = *(const LAS f32x4*)(s_bt + 32 * s + 8 * g + 4);
            v4u o; o.x = pk2(bflo(w.x) * b0[0], bfhi(w.x) * b0[1]); o.y = pk2(bflo(w.y) * b0[2], bfhi(w.y) * b0[3]); o.z = pk2(bflo(w.z) * b1[0], bfhi(w.z) * b1[1]); o.w = pk2(bflo(w.w) * b1[2], bfhi(w.w) * b1[3]);
            vb[s] = __builtin_bit_cast(bf16x8, o); }
#pragma unroll
        for (int I = 0; I < 4; ++I) {
            f32x4 acc = {0.f, 0.f, 0.f, 0.f};
            acc = mfma16(tf[I][0], vb[0], acc);
            if (I >= 2) acc = mfma16(tf[I][1], vb[1], acc);
            U0F[(N * 4 + I) * 64 + lane] = (v2u){pk2(acc[0], acc[1]), pk2(acc[2], acc[3])};
        }
    }
    const bf16* KT = (const bf16*)(ws + WS_KT) + (size_t)(c * 8 + hq) * 128 * 64;
    bf16* Wo = (bf16*)(ws + WS_W) + (size_t)unit * 64 * 128;
#pragma unroll
    for (int s = 0; s < 2; ++s) pf[s] = *(const v4u*)(KT + (size_t)(i16) * 64 + 32 * s + 8 * g);
#pragma unroll 1
    for (int Dt = 0; Dt < 8; ++Dt) {
        bf16x8 ka[2]; v4u cur[2] = {pf[0], pf[1]};
        if (Dt < 7) {
#pragma unroll
            for (int s = 0; s < 2; ++s) pf[s] = *(const v4u*)(KT + (size_t)(16 * (Dt + 1) + i16) * 64 + 32 * s + 8 * g); }
#pragma unroll
        for (int s = 0; s < 2; ++s) { const v4u w = cur[s];
            const f32x4 b0 = *(const LAS f32x4*)(s_bg + 32 * s + 8 * g), b1 = *(const LAS f32x4*)(s_bg + 32 * s + 8 * g + 4);
            v4u o; o.x = pk2(bflo(w.x) * b0[0], bfhi(w.x) * b0[1]); o.y = pk2(bflo(w.y) * b0[2], bfhi(w.y) * b0[3]); o.z = pk2(bflo(w.z) * b1[0], bfhi(w.z) * b1[1]); o.w = pk2(bflo(w.w) * b1[2], bfhi(w.w) * b1[3]);
            ka[s] = __builtin_bit_cast(bf16x8, o); }
#pragma unroll
        for (int I = 0; I < 4; ++I) {
            f32x4 acc = {0.f, 0.f, 0.f, 0.f};
            acc = mfma16(ka[0], tf[I][0], acc);
            if (I >= 2) acc = mfma16(ka[1], tf[I][1], acc);
            *(v2u*)(Wo + (size_t)(16 * I + i16) * 128 + 16 * Dt + 4 * g) = (v2u){pk2(acc[0], acc[1]), pk2(acc[2], acc[3])};
        }
    }
    LDS_WAIT(); asm volatile("" ::: "memory");
}

constexpr int SC_W = 0, SC_Q = 17408, SC_KT = 34816, SC_AQ = 53248, SC_EV = 62464, SC_BUF = 62976, SC_OB = 2 * SC_BUF;
static_assert(SC_OB + 2 * 8192 <= MISC_OFF, "scan LDS");
__device__ __forceinline__ void gdn_scan_wg(const Args& a, int sw, LAS unsigned char* lds, int tid, int wave, int lane) {
    unsigned char* ws = a.ws;
    const int h = sw >> 1, H = sw & 1, hq = h >> 1, i16 = lane & 15, g = lane >> 4;
    const bool loader = wave >= 4; const int lt = tid - 256;
    const bf16* Wg = (const bf16*)(ws + WS_W); const bf16* GQ = (const bf16*)(ws + WS_GQ); const bf16* KTg = (const bf16*)(ws + WS_KT);
    const bf16* AQg = (const bf16*)(ws + WS_AQK); const float* EVg = (const float*)(ws + WS_EV);
    const v2u* U0F = (const v2u*)(ws + WS_U0F); bf16* OA = (bf16*)(ws + WS_OA);
    const int N = 4 * H + (wave & 3);
    f32x4 S[8];
#pragma unroll
    for (int d = 0; d < 8; ++d) S[d] = (f32x4){0.f, 0.f, 0.f, 0.f};
    v2u u0c[4] = {{0u, 0u}, {0u, 0u}, {0u, 0u}, {0u, 0u}};
    v4u sr[15];
#define SCAN_LOAD(cc) do { const int _c = (cc); const int _unit = _c * 16 + h; \
        _Pragma("unroll") for (int k = 0; k < 4; ++k) { const int q = lt + 256 * k; sr[k] = *(const v4u*)(Wg + (size_t)_unit * 8192 + q * 8); } \
        _Pragma("unroll") for (int k = 0; k < 4; ++k) { const int q = lt + 256 * k; sr[4 + k] = *(const v4u*)(GQ + (size_t)(64 * _c + (q >> 4)) * 1024 + hq * 128 + (q & 15) * 8); } \
        _Pragma("unroll") for (int k = 0; k < 4; ++k) { const int q = lt + 256 * k; sr[8 + k] = *(const v4u*)(KTg + (size_t)(_c * 8 + hq) * 8192 + q * 8); } \
        _Pragma("unroll") for (int k = 0; k < 2; ++k) { const int q = lt + 256 * k; sr[12 + k] = *(const v4u*)(AQg + (size_t)_unit * 4096 + q * 8); } \
        sr[14] = *(const v4u*)(EVg + (size_t)_unit * 128 + (lt & 31) * 4); } while (0)
#define SCAN_WRITE(cc) do { const int _c = (cc); LAS unsigned char* _b = lds + (_c & 1) * SC_BUF; \
        _Pragma("unroll") for (int k = 0; k < 4; ++k) { const int q = lt + 256 * k; *(LAS v4u*)(_b + SC_W + (q >> 4) * 272 + (q & 15) * 16) = sr[k]; } \
        _Pragma("unroll") for (int k = 0; k < 4; ++k) { const int q = lt + 256 * k; *(LAS v4u*)(_b + SC_Q + (q >> 4) * 272 + (q & 15) * 16) = sr[4 + k]; } \
        _Pragma("unroll") for (int k = 0; k < 4; ++k) { const int q = lt + 256 * k; *(LAS v4u*)(_b + SC_KT + (q >> 3) * 144 + (q & 7) * 16) = sr[8 + k]; } \
        _Pragma("unroll") for (int k = 0; k < 2; ++k) { const int q = lt + 256 * k; *(LAS v4u*)(_b + SC_AQ + (q >> 3) * 144 + (q & 7) * 16) = sr[12 + k]; } \
        if (lt < 32) *(LAS v4u*)(_b + SC_EV + lt * 16) = sr[14]; } while (0)
#define SCAN_OUT(cc) do { const int _c = (cc); LAS unsigned char* _ob = lds + SC_OB + (_c & 1) * 8192; \
        _Pragma("unroll") for (int k = 0; k < 2; ++k) { const int q = lt + 256 * k; const v4u v = *(const LAS v4u*)(_ob + (q >> 3) * 128 + (q & 7) * 16); \
            *(v4u*)(OA + (size_t)(64 * _c + (q >> 3)) * 2048 + h * 128 + 64 * H + (q & 7) * 8) = v; } } while (0)
#define SCAN_BAR() do { asm volatile("s_waitcnt lgkmcnt(0)" ::: "memory"); __builtin_amdgcn_s_barrier(); asm volatile("" ::: "memory"); } while (0)
    if (loader) {
        SCAN_LOAD(0); SCAN_WRITE(0); SCAN_LOAD(1);
        SCAN_BAR();
#pragma unroll 1
        for (int c = 0; c < 256; ++c) {
            if (c + 1 < 256) SCAN_WRITE(c + 1);
            if (c + 2 < 256) SCAN_LOAD(c + 2);
            if (c >= 1) SCAN_OUT(c - 1);
            SCAN_BAR();
        }
        SCAN_OUT(255);
    } else {
#pragma unroll
        for (int I = 0; I < 4; ++I) u0c[I] = U0F[((size_t)(0 * 16 + h) * 8 + N) * 256 + I * 64 + lane];
        SCAN_BAR();
#pragma unroll 1
        for (int c = 0; c < 256; ++c) {
            LAS unsigned char* b = lds + (c & 1) * SC_BUF;
            v2u u0n[4] = {{0u, 0u}, {0u, 0u}, {0u, 0u}, {0u, 0u}};
            if (c + 1 < 256) {
#pragma unroll
                for (int I = 0; I < 4; ++I) u0n[I] = U0F[((size_t)((c + 1) * 16 + h) * 8 + N) * 256 + I * 64 + lane];
            }
            const float egl = *(const LAS float*)(b + SC_EV + 63 * 4);
            v2u Sb[8];
#pragma unroll
            for (int d = 0; d < 8; ++d) { Sb[d] = (v2u){pk2(S[d][0], S[d][1]), pk2(S[d][2], S[d][3])}; S[d] = S[d] * egl; }
            f32x4 acc[4];
#pragma unroll
            for (int I = 0; I < 4; ++I) acc[I] = (f32x4){0.f, 0.f, 0.f, 0.f};
#pragma unroll
            for (int s = 0; s < 4; ++s) { const bf16x8 Bf = mk8(Sb[2 * s], Sb[2 * s + 1]);
#pragma unroll
                for (int I = 0; I < 4; ++I) {
                    const LAS unsigned char* pw = b + SC_W + (16 * I + i16) * 272 + (32 * s + 4 * g) * 2;
                    acc[I] = mfma16(mk8(*(const LAS v2u*)pw, *(const LAS v2u*)(pw + 32)), Bf, acc[I]); } }
            v2u ub[4], ubk[4];
#pragma unroll
            for (int I = 0; I < 4; ++I) {
                const f32x4 ek4 = *(const LAS f32x4*)(b + SC_EV + 256 + (16 * I + 4 * g) * 4);
                f32x4 u; u[0] = bflo(u0c[I].x) - acc[I][0]; u[1] = bfhi(u0c[I].x) - acc[I][1]; u[2] = bflo(u0c[I].y) - acc[I][2]; u[3] = bfhi(u0c[I].y) - acc[I][3];
                ub[I] = (v2u){pk2(u[0], u[1]), pk2(u[2], u[3])};
                const f32x4 uk = u * ek4; ubk[I] = (v2u){pk2(uk[0], uk[1]), pk2(uk[2], uk[3])}; }
            __builtin_amdgcn_sched_barrier(0);
            f32x4 o[4];
#pragma unroll
            for (int I = 0; I < 4; ++I) o[I] = (f32x4){0.f, 0.f, 0.f, 0.f};
#pragma unroll
            for (int s = 0; s < 4; ++s) { const bf16x8 Bf = mk8(Sb[2 * s], Sb[2 * s + 1]);
#pragma unroll
                for (int I = 0; I < 4; ++I) {
                    const LAS unsigned char* pq = b + SC_Q + (16 * I + i16) * 272 + (32 * s + 4 * g) * 2;
                    o[I] = mfma16(mk8(*(const LAS v2u*)pq, *(const LAS v2u*)(pq + 32)), Bf, o[I]); } }
#pragma unroll
            for (int I = 0; I < 4; ++I) { const f32x4 eg4 = *(const LAS f32x4*)(b + SC_EV + (16 * I + 4 * g) * 4); o[I] = o[I] * eg4; }
#pragma unroll
            for (int I = 0; I < 4; ++I)
#pragma unroll
                for (int sp = 0; sp < 2; ++sp) if (sp == 0 || I >= 2) {
                    const LAS unsigned char* pa = b + SC_AQ + (16 * I + i16) * 144 + (32 * sp + 4 * g) * 2;
                    o[I] = mfma16(mk8(*(const LAS v2u*)pa, *(const LAS v2u*)(pa + 32)), mk8(ub[2 * sp], ub[2 * sp + 1]), o[I]); }
            { LAS unsigned char* ob = lds + SC_OB + (c & 1) * 8192;
#pragma unroll
              for (int I = 0; I < 4; ++I)
#pragma unroll
                  for (int r = 0; r < 4; ++r) *(LAS unsigned short*)(ob + (16 * I + 4 * g + r) * 128 + (16 * (wave & 3) + i16) * 2) = (unsigned short)(pk2(o[I][r], 0.f) & 0xffffu); }
            __builtin_amdgcn_sched_barrier(0);
#pragma unroll
            for (int d = 0; d < 8; ++d)
#pragma unroll
                for (int sp = 0; sp < 2; ++sp) {
                    const LAS unsigned char* pk = b + SC_KT + (16 * d + i16) * 144 + (32 * sp + 4 * g) * 2;
                    S[d] = mfma16(mk8(*(const LAS v2u*)pk, *(const LAS v2u*)(pk + 32)), mk8(ubk[2 * sp], ubk[2 * sp + 1]), S[d]); }
#pragma unroll
            for (int I = 0; I < 4; ++I) u0c[I] = u0n[I];
            SCAN_BAR();
        }
        float* So = a.out + pg8::O_SP + (size_t)h * 128 * 128;
#pragma unroll
        for (int d = 0; d < 8; ++d)
#pragma unroll
            for (int r = 0; r < 4; ++r) So[(size_t)(16 * d + 4 * g + r) * 128 + 16 * N + i16] = S[d][r];
    }
    LDS_WAIT(); __syncthreads();
#undef SCAN_BAR
#undef SCAN_LOAD
#undef SCAN_WRITE
#undef SCAN_OUT
}

__device__ __forceinline__ void gdn_sample_unit(const Args& a, int b, int h, LAS unsigned char* lds, int tid) {
    unsigned char* ws = a.ws;
    const int dv = tid & 127, dq = tid >> 7, hq = h >> 1;
    LAS float* kq = (LAS float*)lds;
    LAS float* red = kq + 256;
    const float* S0 = a.in[4] + ((size_t)(b * 16 + h) * 128) * 128;
    float s[32];
#pragma unroll
    for (int i = 0; i < 32; ++i) s[i] = S0[(size_t)(dq * 32 + i) * 128 + dv];
    const float* SQ = (const float*)(ws + WS_SMP); const float* SK = SQ + 128 * 1024; const float* SV = SQ + 256 * 1024;
    const float* gb = (const float*)(ws + WS_GB);
    bf16* OA = (bf16*)(ws + WS_OA);
    for (int t = 0; t < 16; ++t) {
        const int row = 16 * b + t;
        __syncthreads();
        if (tid < 128) kq[tid] = SK[(size_t)row * 1024 + hq * 128 + tid]; else if (tid < 256) kq[tid] = SQ[(size_t)row * 1024 + hq * 128 + tid - 128];
        const float vt = SV[(size_t)row * 2048 + h * 128 + dv];
        const float al = __expf(gb[(size_t)(PROWS + row) * 32 + h]), be = gb[(size_t)(PROWS + row) * 32 + 16 + h];
        __syncthreads();
        float p = 0.f;
#pragma unroll
        for (int i = 0; i < 32; ++i) p += kq[dq * 32 + i] * s[i];
        red[dq * 128 + dv] = p;
        __syncthreads();
        const float rr = (red[dv] + red[128 + dv]) + (red[256 + dv] + red[384 + dv]);
        const float delta = be * (vt - al * rr);
        float po = 0.f;
#pragma unroll
        for (int i = 0; i < 32; ++i) { s[i] = al * s[i] + kq[dq * 32 + i] * delta; po += kq[128 + dq * 32 + i] * s[i]; }
        __syncthreads();
        red[dq * 128 + dv] = po;
        __syncthreads();
        if (dq == 0) { const float ov = (red[dv] + red[128 + dv]) + (red[256 + dv] + red[384 + dv]);
            OA[(size_t)(PROWS + row) * 2048 + h * 128 + dv] = (bf16)(pk2(ov, 0.f) & 0xffffu); }
    }
    float* So = a.out + pg8::O_SS + ((size_t)(b * 16 + h) * 128) * 128;
#pragma unroll
    for (int i = 0; i < 32; ++i) So[(size_t)(dq * 32 + i) * 128 + dv] = s[i];
    __syncthreads();
}

constexpr int AT_K = 0, AT_V = 64 * 272, AT_WM = AT_V + 64 * 288;
constexpr int PAST = 2048;
typedef short s16x4 __attribute__((ext_vector_type(4)));
template <bool SAMPLE>
__device__ __forceinline__ void attn_unit(const Args& a, int qb, int hh, LAS unsigned char* lds, int tid, int wave, int lane) {
    unsigned char* ws = a.ws;
    const int i16 = lane & 15, g = lane >> 4;
    const bf16* QSB = (const bf16*)(ws + WS_QSB); const bf16* KSB = (const bf16*)(ws + WS_KSB); const bf16* VSB = (const bf16*)(ws + WS_VSB); bf16* OB = (bf16*)(ws + WS_OB);
    const bool wvalid = !SAMPLE || wave == 0;
    const int qrow = SAMPLE ? PROWS + 16 * qb + i16 : 128 * qb + 16 * wave + i16;
    const int qpos = SAMPLE ? (wvalid ? PAST + i16 : -1) : qrow;
    bf16x8 qf[4];
#pragma unroll
    for (int s = 0; s < 4; ++s) qf[s] = *(const bf16x8*)(QSB + (size_t)qrow * 2048 + hh * 128 + 32 * s + 8 * g);
    float carry = 0.f;
    f32x4 oacc[8];
#pragma unroll
    for (int d = 0; d < 8; ++d) oacc[d] = (f32x4){0.f, 0.f, 0.f, 0.f};
    const int kb_hi = SAMPLE ? 32 : 2 * qb + 1;
    LAS float* wm = (LAS float*)(lds + AT_WM);
    for (int kb = kb_hi; kb >= 0; --kb) {
        if (kb != kb_hi) { const float m = wave_max(wvalid ? carry : -1e30f); if (lane == 0) wm[wave] = m; }
        LDS_WAIT(); __syncthreads();
        if (kb != kb_hi) { float m = wm[0];
#pragma unroll
            for (int w = 1; w < 8; ++w) m = fmaxf(m, wm[w]);
            if (m < -104.f) break; }
#pragma unroll
        for (int k = 0; k < 2; ++k) { const int q = tid + 512 * k, row = q >> 4, cc = q & 15; v4u kv, vv;
            if (!SAMPLE) { const size_t off = (size_t)(64 * kb + row) * 2048 + hh * 128 + cc * 8; kv = *(const v4u*)(KSB + off); vv = *(const v4u*)(VSB + off); }
            else { const int pos = 64 * kb + row;
                if (pos < PAST) { const size_t off = (((size_t)qb * PAST + pos) * 16 + hh) * 128 + cc * 8; const f32x4 k0 = *(const f32x4*)(a.in[2] + off), k1 = *(const f32x4*)(a.in[2] + off + 4), v0 = *(const f32x4*)(a.in[3] + off), v1 = *(const f32x4*)(a.in[3] + off + 4);
                    kv = (v4u){pk2(k0[0], k0[1]), pk2(k0[2], k0[3]), pk2(k1[0], k1[1]), pk2(k1[2], k1[3])}; vv = (v4u){pk2(v0[0], v0[1]), pk2(v0[2], v0[3]), pk2(v1[0], v1[1]), pk2(v1[2], v1[3])}; }
                else if (pos < PAST + 16) { const size_t off = (size_t)(PROWS + 16 * qb + pos - PAST) * 2048 + hh * 128 + cc * 8; kv = *(const v4u*)(KSB + off); vv = *(const v4u*)(VSB + off); }
                else { kv = (v4u){0u, 0u, 0u, 0u}; vv = kv; } }
            *(LAS v4u*)(lds + AT_K + row * 272 + cc * 16) = kv; *(LAS v4u*)(lds + AT_V + row * 288 + cc * 16) = vv; }
        LDS_WAIT(); __syncthreads();
        f32x4 z[4];
#pragma unroll
        for (int T = 0; T < 4; ++T) { z[T] = (f32x4){0.f, 0.f, 0.f, 0.f};
#pragma unroll
            for (int s = 0; s < 4; ++s) z[T] = mfma16(*(const LAS bf16x8*)(lds + AT_K + (16 * T + i16) * 272 + (32 * s + 8 * g) * 2), qf[s], z[T]); }
        float run = carry; v2u pb[4];
#pragma unroll
        for (int T = 3; T >= 0; --T) {
            float lf[4], ls[4]; bool vd[4];
#pragma unroll
            for (int r = 0; r < 4; ++r) { const int kpos = 64 * kb + 16 * T + 4 * g + r; vd[r] = kpos < qpos; const float zz = z[T][r] * 0.08838834764831845f; const float sp = softplusf(zz);
                lf[r] = vd[r] ? -sp : 0.f; ls[r] = zz - sp; }
            const float G = (lf[0] + lf[1]) + (lf[2] + lf[3]);
            const float G1 = __shfl_xor(G, 16), G2 = __shfl_xor(G, 32), G3 = __shfl_xor(G, 48);
            const float above = (g == 0) ? (G1 + G2 + G3) : ((g == 1) ? (G2 + G3) : ((g == 2) ? G1 : 0.f));
            const float t3 = run + above, t2 = t3 + lf[3], t1 = t2 + lf[2], t0 = t1 + lf[1];
            const float a0 = vd[0] ? __expf(ls[0] + t0) : 0.f, a1 = vd[1] ? __expf(ls[1] + t1) : 0.f, a2 = vd[2] ? __expf(ls[2] + t2) : 0.f, a3 = vd[3] ? __expf(ls[3] + t3) : 0.f;
            pb[T] = (v2u){pk2(a0, a1), pk2(a2, a3)};
            run += (G + G1) + (G2 + G3);
        }
        carry = run;
        const int q4 = i16 >> 2, p4 = i16 & 3;
#pragma unroll
        for (int sp = 0; sp < 2; ++sp) { const bf16x8 Bf = mk8(pb[2 * sp], pb[2 * sp + 1]);
#pragma unroll
            for (int d = 0; d < 8; ++d) {
                LAS unsigned char* p0 = lds + AT_V + (32 * sp + 4 * g + q4) * 288 + (16 * d + 4 * p4) * 2;
                const s16x4 a0 = __builtin_amdgcn_ds_read_tr16_b64_v4i16((LAS s16x4*)p0), a1 = __builtin_amdgcn_ds_read_tr16_b64_v4i16((LAS s16x4*)(p0 + 16 * 288));
                bf16x8 Af; Af[0] = a0[0]; Af[1] = a0[1]; Af[2] = a0[2]; Af[3] = a0[3]; Af[4] = a1[0]; Af[5] = a1[1]; Af[6] = a1[2]; Af[7] = a1[3];
                oacc[d] = mfma16(Af, Bf, oacc[d]); } }
    }
    if (wvalid) {
#pragma unroll
        for (int d = 0; d < 8; ++d) *(v2u*)(OB + (size_t)qrow * 2048 + hh * 128 + 16 * d + 4 * g) = (v2u){pk2(oacc[d][0], oacc[d][1]), pk2(oacc[d][2], oacc[d][3])};
    }
    LDS_WAIT(); __syncthreads();
}

__device__ __forceinline__ void p5_oanorm(const Args& a, int G, int wave, int lane) {
    unsigned char* ws = a.ws; bf16* OA = (bf16*)(ws + WS_OA); const bf16* Z = (const bf16*)(ws + WS_Z);
    const int gw = (int)blockIdx.x * NWAVES + wave, NGW = G * NWAVES;
    const int c8 = (lane & 15) * 8;
    const f32x4 w0 = *(const f32x4*)(a.in[11] + c8), w1 = *(const f32x4*)(a.in[11] + c8 + 4);
    for (int it = gw; it < REALROWS * 4; it += NGW) { const int m = it >> 2, hd = (it & 3) * 4 + (lane >> 4);
        const size_t off = (size_t)m * 2048 + hd * 128 + c8;
        f32x4 o0, o1, z0, z1; pg8::unpack8(*(const v4u*)(OA + off), o0, o1); pg8::unpack8(*(const v4u*)(Z + off), z0, z1);
        float ss = (o0[0] * o0[0] + o0[1] * o0[1]) + (o0[2] * o0[2] + o0[3] * o0[3]) + (o1[0] * o1[0] + o1[1] * o1[1]) + (o1[2] * o1[2] + o1[3] * o1[3]);
        ss += __shfl_xor(ss, 1); ss += __shfl_xor(ss, 2); ss += __shfl_xor(ss, 4); ss += __shfl_xor(ss, 8);
        const float r = 1.0f / sqrtf(ss * (1.0f / 128.0f) + 1e-6f);
#pragma unroll
        for (int j = 0; j < 4; ++j) { o0[j] = o0[j] * r * w0[j] * (z0[j] * __builtin_amdgcn_rcpf(1.0f + __expf(-z0[j]))); o1[j] = o1[j] * r * w1[j] * (z1[j] * __builtin_amdgcn_rcpf(1.0f + __expf(-z1[j]))); }
        *(v4u*)(OA + off) = pg8::pack8(o0, o1);
    }
}

template <int PH_LO, int PH_HI>
__global__ void __launch_bounds__(NWAVES * 64, 2) hybrid_fwd(Args args) {
    extern __shared__ __attribute__((aligned(16))) unsigned char lds_raw[];
    LAS unsigned char* lds = (LAS unsigned char*)lds_raw;
    const int G = gridDim.x;
    volatile LAS unsigned* MISC = (volatile LAS unsigned*)(lds + MISC_OFF);
    if (threadIdx.x < 64) MISC[threadIdx.x] = 0u;
#define PHASE_IDS() int tid = threadIdx.x; asm volatile("" : "+v"(tid)); const int lane = tid & 63, wave = __builtin_amdgcn_readfirstlane(tid >> 6); (void)lane; (void)wave
    __syncthreads();
    unsigned char* ws = args.ws;
    unsigned* ctl = (unsigned*)(ws + WS_CTL);
    XcdBarrier bar; bar.bar = ctl + CW_BAR; bar.x = 0; bar.st = nullptr;
    if (PH_HI - PH_LO > 1) bar = xcd_barrier_post(ctl + CW_BAR, MISC + 8);
#define GRID_BAR() do { xcd_barrier(bar); } while (0)
#define IN(k) (PH_LO <= (k) && (k) < PH_HI)
#define BOTH(k) (IN(k) && IN((k) + 1))
    bf16* XN = (bf16*)(ws + WS_XN);

    if constexpr (IN(0)) { PHASE_IDS(); p0_prologue(args, lds, G, tid, wave, lane); if constexpr (BOTH(0)) GRID_BAR(); }

    if constexpr (IN(1)) { PHASE_IDS();
        pg8::Gemm g{XN, (const bf16*)(ws + WS_WIN), MT, NIN, D}; pg8::StaticOrder S; S.init(MT, NIN, G, (int)blockIdx.x, D);
        pg8::EpiInProj E{(bf16*)(ws + WS_QKVRAW), (bf16*)(ws + WS_Z), (bf16*)(ws + WS_QSB), (bf16*)(ws + WS_KSB), (bf16*)(ws + WS_VSB), (bf16*)(ws + WS_GATES), (float*)(ws + WS_AB), args.out};
        pg8::gemm_phase<pg8::EpiInProj, pg8::StaticOrder, true, true>(lds, g, S, E);
        if constexpr (BOTH(1)) GRID_BAR();
    }

    if constexpr (IN(2)) { PHASE_IDS(); p2_conv(args, G, tid, wave, lane); if constexpr (BOTH(2)) GRID_BAR(); }

    if constexpr (IN(3)) { PHASE_IDS();
        const int gw = (int)blockIdx.x * NWAVES + wave, NGW = G * NWAVES;
        for (int it = gw; it < 4096; it += NGW) gdn_prep_unit(args, it >> 4, it & 15, lds + wave * PREP_WL, lane);
        if constexpr (BOTH(3)) GRID_BAR();
    }

    if constexpr (IN(4)) { PHASE_IDS();
        if (blockIdx.x < 32) gdn_scan_wg(args, (int)blockIdx.x, lds, tid, wave, lane);
        for (;;) {
            __syncthreads();
            if (tid == 0) MISC[16] = __hip_atomic_fetch_add(ctl + CW_QUEUE, 1u, __ATOMIC_RELAXED, __HIP_MEMORY_SCOPE_AGENT);
            __syncthreads();
            const unsigned qi = MISC[16];
            if (qi >= 2304u) break;
            if (qi < 2048u) attn_unit<false>(args, 127 - (int)(qi >> 4), (int)(qi & 15u), lds, tid, wave, lane);
            else if (qi < 2176u) attn_unit<true>(args, (int)((qi - 2048u) >> 4), (int)(qi & 15u), lds, tid, wave, lane);
            else gdn_sample_unit(args, (int)((qi - 2176u) >> 4), (int)(qi & 15u), lds, tid);
        }
        if constexpr (BOTH(4)) GRID_BAR();
    }

    if constexpr (IN(5)) { PHASE_IDS(); p5_oanorm(args, G, wave, lane); if constexpr (BOTH(5)) GRID_BAR(); }

    if constexpr (IN(6)) { PHASE_IDS();
        pg8::Gemm g{(const bf16*)(ws + WS_OA), (const bf16*)(ws + WS_WGDN), MT, D, 2048}; pg8::StaticOrder S; S.init(MT, D, G, (int)blockIdx.x, 2048);
        pg8::EpiGate<0> E{(const bf16*)(ws + WS_GATES), (bf16*)(ws + WS_M)};
        pg8::gemm_phase<pg8::EpiGate<0>, pg8::StaticOrder, true, true>(lds, g, S, E);
        if constexpr (BOTH(6)) GRID_BAR();
    }
    if constexpr (IN(7)) { PHASE_IDS();
        pg8::Gemm g{(const bf16*)(ws + WS_OB), (const bf16*)(ws + WS_WSB), MT, D, 2048}; pg8::StaticOrder S; S.init(MT, D, G, (int)blockIdx.x, 2048);
        pg8::EpiGate<1> E{(const bf16*)(ws + WS_GATES), (bf16*)(ws + WS_M)};
        pg8::gemm_phase<pg8::EpiGate<1>, pg8::StaticOrder, true, true>(lds, g, S, E);
        if constexpr (BOTH(7)) GRID_BAR();
    }
    if constexpr (IN(8)) { PHASE_IDS();
        pg8::Gemm g{(const bf16*)(ws + WS_M), (const bf16*)(ws + WS_WOUT), MT, D, D}; pg8::MixOrder S; S.init_mix(D, D, G, (int)blockIdx.x, 16);
        pg8::EpiOutRes E{args.in[0], args.in[1], args.out};
        pg8::gemm_phase<pg8::EpiOutRes, pg8::MixOrder, true, true>(lds, g, S, E);
        if constexpr (BOTH(8)) GRID_BAR();
    }
    if constexpr (IN(9)) { PHASE_IDS();
        const int gw = (int)blockIdx.x * NWAVES + wave, NGW = G * NWAVES;
        for (int m = gw; m < MT; m += NGW) rms_row_to_bf16(m < REALROWS ? args.out + (size_t)m * D : nullptr, args.in[15], XN + (size_t)m * D, lane);
        if constexpr (BOTH(9)) GRID_BAR();
    }
    if constexpr (IN(10)) { PHASE_IDS();
        pg8::Gemm g{XN, (const bf16*)(ws + WS_WUP), MT, DFF, D}; pg8::StaticOrder S; S.init(MT, DFF, G, (int)blockIdx.x, D);
        pg8::EpiUp E{(bf16*)(ws + WS_U)};
        pg8::gemm_phase<pg8::EpiUp, pg8::StaticOrder, true, true>(lds, g, S, E);
        if constexpr (BOTH(10)) GRID_BAR();
    }
    if constexpr (IN(11)) { PHASE_IDS();
        pg8::Gemm g{(const bf16*)(ws + WS_U), (const bf16*)(ws + WS_WDOWN), MT, D, DFF}; pg8::MixOrder S; S.init_mix(D, DFF, G, (int)blockIdx.x, 16);
        pg8::EpiDownRes E{args.out};
        pg8::gemm_phase<pg8::EpiDownRes, pg8::MixOrder, true, true>(lds, g, S, E);
        if constexpr (BOTH(11)) GRID_BAR();
    }
    if constexpr (IN(12)) { PHASE_IDS();
        const int gw = (int)blockIdx.x * NWAVES + wave, NGW = G * NWAVES;
        for (int m = gw; m < REALROWS; m += NGW) rms_row_inplace(args.out + (size_t)m * D, args.in[18], lane);
    }
#undef IN
#undef BOTH
#undef GRID_BAR
}

#if DBG_STAGE
__global__ void dbg_finalize(float* out, int stage) {
    const size_t n = pg8::O_END;
    for (size_t i = (size_t)blockIdx.x * blockDim.x + threadIdx.x; i < n; i += (size_t)gridDim.x * blockDim.x) {
        bool keep;
        if (stage == 1) keep = (i >= pg8::O_KP && i < pg8::O_SP) || (i >= pg8::O_CP && i < pg8::O_SS) || (i >= pg8::O_CS);
        else if (stage == 2) keep = (i >= pg8::O_SP && i < pg8::O_CP) || (i >= pg8::O_SS && i < pg8::O_CS);
        else if (stage == 3) keep = (i >= pg8::O_SS && i < pg8::O_CS);
        else keep = (i >= pg8::O_SP && i < pg8::O_CP);
        out[i] = keep ? 3.0f * out[i] : 0.f;
    }
}
#endif


template <int LO, int HI> static bool set_attr_one() { return hipFuncSetAttribute((const void*)hybrid_fwd<LO, HI>, hipFuncAttributeMaxDynamicSharedMemorySize, LDS_BYTES) == hipSuccess; }
template <int LO, int HI> static void launch_one(int grid, hipStream_t stream, const Args& a) { hipLaunchKernelGGL((hybrid_fwd<LO, HI>), dim3(grid), dim3(NWAVES * 64), LDS_BYTES, stream, a); }
#if MK_N_LAUNCHES == 1
static bool set_attrs() { return set_attr_one<0, NPH>(); }
static void launch_all(int grid, hipStream_t stream, const Args& a, int last) { (void)last; launch_one<0, NPH>(grid, stream, a); }
#else
static bool set_attrs() { return set_attr_one<0, 1>() && set_attr_one<1, 2>() && set_attr_one<2, 3>() && set_attr_one<3, 4>() && set_attr_one<4, 5>() && set_attr_one<5, 6>() && set_attr_one<6, 7>() && set_attr_one<7, 8>() && set_attr_one<8, 9>() && set_attr_one<9, 10>() && set_attr_one<10, 11>() && set_attr_one<11, 12>() && set_attr_one<12, 13>(); }
static void launch_all(int grid, hipStream_t stream, const Args& a, int last) {
    if (last > 0) launch_one<0, 1>(grid, stream, a); if (last > 1) launch_one<1, 2>(grid, stream, a); if (last > 2) launch_one<2, 3>(grid, stream, a); if (last > 3) launch_one<3, 4>(grid, stream, a);
    if (last > 4) launch_one<4, 5>(grid, stream, a); if (last > 5) launch_one<5, 6>(grid, stream, a); if (last > 6) launch_one<6, 7>(grid, stream, a); if (last > 7) launch_one<7, 8>(grid, stream, a);
    if (last > 8) launch_one<8, 9>(grid, stream, a); if (last > 9) launch_one<9, 10>(grid, stream, a); if (last > 10) launch_one<10, 11>(grid, stream, a); if (last > 11) launch_one<11, 12>(grid, stream, a);
    if (last > 12) launch_one<12, 13>(grid, stream, a);
}
#endif
extern "C" void kernel_launch(void* const* d_in, const int* in_sizes, int n_in, void* d_out, int out_size, void* d_ws, size_t ws_size, hipStream_t stream) {
    static int grid = 0;
    if (grid == 0) {
        if (n_in != 19 || (size_t)out_size != pg8::O_END || ws_size < WS_END) { fprintf(stderr, "kernel_launch: shape mismatch: n_in %d out %d ws %zu (need >= %zu); nothing launched\n", n_in, out_size, ws_size, (size_t)WS_END); grid = -1; return; }
        int dev = 0, cus = 0, per_cu = 0;
        if (hipGetDevice(&dev) != hipSuccess || hipDeviceGetAttribute(&cus, hipDeviceAttributeMultiprocessorCount, dev) != hipSuccess) { grid = -1; return; }
        if (!set_attrs()) { fprintf(stderr, "kernel_launch: hipFuncSetAttribute failed\n"); grid = -1; return; }
        (void)hipGetLastError();
        grid = cus;
        if (grid < 32) { grid = -1; return; }
    }
    if (grid < 0) return;
    if (hipMemsetAsync((char*)d_ws + WS_CTL, 0, CTL_ZERO_BYTES, stream) != hipSuccess) return;
    Args a{};
    for (int i = 0; i < 19; ++i) a.in[i] = (const float*)d_in[i];
    a.out = (float*)d_out; a.ws = (unsigned char*)d_ws;
#if DBG_STAGE == 1
    const int last = 2;
#elif DBG_STAGE >= 2
    const int last = 5;
#else
    const int last = NPH;
#endif
    launch_all(grid, stream, a, last);
#if DBG_STAGE
    hipLaunchKernelGGL(dbg_finalize, dim3(2048), dim3(256), 0, stream, (float*)d_out, (int)DBG_STAGE);
#endif
}
```
